# Optimizing an MI355X kernel written in HIP

```python
import math
import jax
import jax.numpy as jnp
from jax import lax
import numpy as np

D_MODEL = 1024
BATCH = 2
SEQ = 8192
DEPTH = 4
DEC_BATCH = 8
DEC_SEQ = 4096
PAST_LEN = 128

F32 = jnp.float32
N_MEM = 256
GRID_W = 64
Q_BLOCK = 128
D_FF = 4 * D_MODEL
NORM_EPS = 1e-6
ROPE_THETA = 500000.0
AXIAL_THETA = 10000.0
NEG_INF = -1e30
N_MIXERS = 4

A_PATTERNS = ((128, 1), (512, 4), (2048, 16))
A_GROUPS = len(A_PATTERNS)
A_HEADS = 8
A_HEAD_DIM = 64
A_ROT = A_HEAD_DIM // 4
A_IN = A_GROUPS * 3 * A_HEADS * A_HEAD_DIM
B_HEADS = 16
B_KV_HEADS = 4
B_HEAD_DIM = 64
B_IN = (B_HEADS + 2 * B_KV_HEADS) * B_HEAD_DIM
C_HEADS = 8
C_DIM = 64
C_ROT = C_DIM // 4
C_IN = 3 * C_HEADS * 2 * C_DIM
D_HEADS = 16
D_Q_RANK = 384
D_KV_RANK = 256
D_NOPE = 64
D_ROPE = 32
D_V = 64
D_IN = D_Q_RANK + D_KV_RANK + D_ROPE
X_HEADS = 4
X_HEAD_DIM = 128
N_A = (DEPTH + 3) // 4
N_B = (DEPTH + 2) // 4
N_C = (DEPTH + 1) // 4
N_D = DEPTH // 4

kernel_name = 'hybrid_bidir_encoder_interleaved'


def rmsnorm(x, g):
    xf = x.astype(F32)
    y = xf * lax.rsqrt(jnp.mean(xf * xf, axis=-1, keepdims=True) + NORM_EPS)
    return (y * g.astype(F32)).astype(x.dtype)


def rope(x, pos, theta, rot):
    half = rot // 2
    inv_freq = jnp.exp(jnp.arange(half, dtype=F32) * (-2.0 * math.log(theta) / rot))
    ang = pos.astype(F32)[:, None] * inv_freq[None, :]
    bshape = (1, pos.shape[0]) + (1,) * (x.ndim - 3) + (half,)
    cos = jnp.cos(ang).reshape(bshape).astype(x.dtype)
    sin = jnp.sin(ang).reshape(bshape).astype(x.dtype)
    x1 = x[..., :half]
    x2 = x[..., half:rot]
    return jnp.concatenate([x1 * cos - x2 * sin, x2 * cos + x1 * sin, x[..., rot:]], axis=-1)


def axial_rope(x, rows, cols):
    half = x.shape[-1] // 2
    return jnp.concatenate([rope(x[..., :half], rows, AXIAL_THETA, half),
                            rope(x[..., half:], cols, AXIAL_THETA, half)], axis=-1)


def to_blocks(t):
    b, s = t.shape[:2]
    return jnp.moveaxis(t.reshape((b, s // Q_BLOCK, Q_BLOCK) + t.shape[2:]), 1, 0)


def from_blocks(t):
    nb, b, qb = t.shape[:3]
    return jnp.moveaxis(t, 0, 1).reshape((b, nb * qb) + t.shape[3:])


def dilated_window_attention(q, k, v, window, dilation):
    b, s, h, dh = q.shape
    n = window // (2 * dilation)
    L = s // dilation
    c = n
    nb = -(-L // c)
    lp = nb * c

    def split(t):
        t = t.reshape(b, L, dilation, h, dh).transpose(0, 2, 1, 3, 4)
        t = jnp.pad(t, ((0, 0), (0, 0), (0, lp - L), (0, 0), (0, 0)))
        return t.reshape(b, dilation, nb, c, h, dh)

    def neighbours(t):
        tp = jnp.pad(t, ((0, 0), (0, 0), (1, 1), (0, 0), (0, 0), (0, 0)))
        return jnp.concatenate([tp[:, :, :-2], tp[:, :, 1:-1], tp[:, :, 2:]], axis=3)

    qb = split(q)
    kn = neighbours(split(k))
    vn = neighbours(split(v))
    iq = jnp.arange(nb)[:, None, None] * c + jnp.arange(c)[None, :, None]
    ik = (jnp.arange(nb)[:, None, None] - 1) * c + jnp.arange(3 * c)[None, None, :]
    valid = (jnp.abs(iq - ik) <= n) & (ik >= 0) & (ik < L)
    sc = jnp.einsum('brnqhd,brnkhd->brnhqk', qb, kn).astype(F32) * dh ** -0.5
    sc = jnp.where(valid[None, None, :, None], sc, NEG_INF)
    mx = jnp.max(sc, axis=-1, keepdims=True)
    e = jnp.exp(sc - mx)
    den = jnp.sum(e, axis=-1, keepdims=True)
    lse = (mx + jnp.log(den))[..., 0]
    o = jnp.einsum('brnhqk,brnkhd->brnqhd', (e / den).astype(v.dtype), vn)
    o = o.reshape(b, dilation, lp, h, dh)[:, :, :L].transpose(0, 2, 1, 3, 4).reshape(b, s, h, dh)
    lse = lse.transpose(0, 1, 2, 4, 3).reshape(b, dilation, lp, h)[:, :, :L]
    lse = lse.transpose(0, 2, 1, 3).reshape(b, s, h)
    return o, lse


def mixer_dilated(h, w_in, w_out, pos):
    b, s, _ = h.shape
    qkv = (h @ w_in).reshape(b, s, A_GROUPS, 3, A_HEADS, A_HEAD_DIM)
    outs = []
    lses = []
    for g, (window, dil) in enumerate(A_PATTERNS):
        q = rope(qkv[:, :, g, 0], pos, ROPE_THETA, A_ROT)
        k = rope(qkv[:, :, g, 1], pos, ROPE_THETA, A_ROT)
        o, lse = dilated_window_attention(q, k, qkv[:, :, g, 2], window, dil)
        outs.append(o)
        lses.append(lse)
    alpha = jax.nn.softmax(jnp.stack(lses), axis=0)
    o = jnp.einsum('gbsh,gbshd->bshd', alpha.astype(h.dtype), jnp.stack(outs))
    return o.reshape(b, s, A_HEADS * A_HEAD_DIM) @ w_out


def mixer_gqa_axial(h, w_in, q_gain, k_gain, w_out, rows, cols):
    b, s, _ = h.shape
    dh = B_HEAD_DIM
    grp = B_HEADS // B_KV_HEADS
    qkv = h @ w_in
    q = qkv[..., :B_HEADS * dh].reshape(b, s, B_HEADS, dh)
    k = qkv[..., B_HEADS * dh:(B_HEADS + B_KV_HEADS) * dh].reshape(b, s, B_KV_HEADS, dh)
    v = qkv[..., (B_HEADS + B_KV_HEADS) * dh:].reshape(b, s, B_KV_HEADS, dh)
    q = axial_rope(rmsnorm(q, q_gain), rows, cols).reshape(b, s, B_KV_HEADS, grp, dh)
    k = axial_rope(rmsnorm(k, k_gain), rows, cols)
    scale = dh ** -0.5

    def block(qb):
        sc = jnp.einsum('bqhgd,bkhd->bhgqk', qb, k).astype(F32) * scale
        p = jax.nn.softmax(sc, axis=-1).astype(v.dtype)
        return jnp.einsum('bhgqk,bkhd->bqhgd', p, v)

    o = from_blocks(lax.map(block, to_blocks(q)))
    return o.reshape(b, s, B_HEADS * dh) @ w_out


def mixer_diff(h, w_in, lq1, lk1, lq2, lk2, sub_gain, w_out, pos, lambda_init):
    b, s, _ = h.shape
    qkv = (h @ w_in).reshape(b, s, 3, C_HEADS, 2 * C_DIM)
    q = rope(qkv[:, :, 0].reshape(b, s, C_HEADS, 2, C_DIM), pos, ROPE_THETA, C_ROT)
    k = rope(qkv[:, :, 1].reshape(b, s, C_HEADS, 2, C_DIM), pos, ROPE_THETA, C_ROT)
    v = qkv[:, :, 2]
    lam = (jnp.exp(jnp.sum(lq1.astype(F32) * lk1.astype(F32)))
           - jnp.exp(jnp.sum(lq2.astype(F32) * lk2.astype(F32))) + lambda_init)
    scale = C_DIM ** -0.5

    def block(qb):
        sc = jnp.einsum('bqhcd,bkhcd->bchqk', qb, k).astype(F32) * scale
        p = jax.nn.softmax(sc, axis=-1)
        a = (p[:, 0] - lam * p[:, 1]).astype(v.dtype)
        return jnp.einsum('bhqk,bkhd->bqhd', a, v)

    o = from_blocks(lax.map(block, to_blocks(q)))
    o = rmsnorm(o, sub_gain) * (1.0 - lambda_init)
    return o.reshape(b, s, C_HEADS * 2 * C_DIM) @ w_out


def mixer_mla(h, w_in, q_gain, kv_gain, w_uq, w_ukv, w_out, pos):
    b, s, _ = h.shape
    cmb = h @ w_in
    c_q = rmsnorm(cmb[..., :D_Q_RANK], q_gain)
    c_kv = rmsnorm(cmb[..., D_Q_RANK:D_Q_RANK + D_KV_RANK], kv_gain)
    k_rope = rope(cmb[..., D_Q_RANK + D_KV_RANK:][:, :, None, :], pos, ROPE_THETA, D_ROPE)[:, :, 0]
    q = (c_q @ w_uq).reshape(b, s, D_HEADS, D_NOPE + D_ROPE)
    q_nope = q[..., :D_NOPE]
    q_rope = rope(q[..., D_NOPE:], pos, ROPE_THETA, D_ROPE)
    kv = (c_kv @ w_ukv).reshape(b, s, D_HEADS, D_NOPE + D_V)
    k_nope = kv[..., :D_NOPE]
    v = kv[..., D_NOPE:]
    scale = (D_NOPE + D_ROPE) ** -0.5

    def block(qs):
        qn, qr = qs
        sc = (jnp.einsum('bqhd,bkhd->bhqk', qn, k_nope)
              + jnp.einsum('bqhr,bkr->bhqk', qr, k_rope)).astype(F32) * scale
        p = jax.nn.softmax(sc, axis=-1).astype(v.dtype)
        return jnp.einsum('bhqk,bkhd->bqhd', p, v)

    o = from_blocks(lax.map(block, (to_blocks(q_nope), to_blocks(q_rope))))
    return o.reshape(b, s, D_HEADS * D_V) @ w_out


def memory_cross_attention(h, mem, mem_gain, w_q, w_kv, w_o):
    b, s, _ = h.shape
    n_mem = mem.shape[1]
    m = rmsnorm(mem, mem_gain)
    q = (h @ w_q).reshape(b, s, X_HEADS, X_HEAD_DIM)
    kv = (m @ w_kv).reshape(b, n_mem, 2, X_HEADS, X_HEAD_DIM)
    sc = jnp.einsum('bqhd,bmhd->bhqm', q, kv[:, :, 0]).astype(F32) * X_HEAD_DIM ** -0.5
    p = jax.nn.softmax(sc, axis=-1).astype(h.dtype)
    o = jnp.einsum('bhqm,bmhd->bqhd', p, kv[:, :, 1])
    return o.reshape(b, s, X_HEADS * X_HEAD_DIM) @ w_o


def sqrelu_mlp(h, w_in, w_out):
    a = jax.nn.relu(h @ w_in)
    return (a * a) @ w_out


def run_trunk(x, mem, p):
    s = x.shape[1]
    n_rows = s // GRID_W
    pos = jnp.arange(s, dtype=F32)
    rows = jnp.repeat(jnp.arange(n_rows, dtype=F32), GRID_W)
    cols = jnp.tile(jnp.arange(GRID_W, dtype=F32), n_rows)
    for i in range(DEPTH):
        m, j = i % N_MIXERS, i // N_MIXERS
        h = rmsnorm(x, p['norm_mix'][i])
        if m == 0:
            mix = mixer_dilated(h, p['a_w_in'][j], p['a_w_out'][j], pos)
        elif m == 1:
            mix = mixer_gqa_axial(h, p['b_w_in'][j], p['b_q_norm'][j], p['b_k_norm'][j],
                                  p['b_w_out'][j], rows, cols)
        elif m == 2:
            mix = mixer_diff(h, p['c_w_in'][j], p['c_lambda_q1'][j], p['c_lambda_k1'][j],
                             p['c_lambda_q2'][j], p['c_lambda_k2'][j], p['c_sub_norm'][j],
                             p['c_w_out'][j], pos, 0.8 - 0.6 * math.exp(-0.3 * i))
        else:
            mix = mixer_mla(h, p['d_w_in'][j], p['d_q_norm'][j], p['d_kv_norm'][j],
                            p['d_w_uq'][j], p['d_w_ukv'][j], p['d_w_out'][j], pos)
        x = x + mix
        x = x + memory_cross_attention(rmsnorm(x, p['norm_x'][i]), mem, p['norm_mem'][i],
                                       p['w_xq'][i], p['w_xkv'][i], p['w_xo'][i])
        x = x + sqrelu_mlp(rmsnorm(x, p['norm_mlp'][i]), p['w_mlp_in'][i], p['w_mlp_out'][i])
    return rmsnorm(x, p['final_norm'])


def setup_inputs(seed: int = 0) -> dict:
    key = jax.random.key(seed)
    ks = iter(jax.random.split(key, 40))

    def act(shape):
        return jax.random.normal(next(ks), shape, F32)

    def w(shape, fan_in):
        return jax.random.normal(next(ks), shape, F32) * fan_in ** -0.5

    def gain(shape):
        return 1.0 + 0.05 * jax.random.normal(next(ks), shape, F32)

    def small(shape):
        return 0.1 * jax.random.normal(next(ks), shape, F32)

    D = D_MODEL
    return {
        'x_prompt': act((BATCH, SEQ, D)),
        'x_sample': act((DEC_BATCH, DEC_SEQ, D)),
        'mem_prompt': act((BATCH, N_MEM, D)),
        'mem_sample': act((DEC_BATCH, N_MEM, D)),
        'norm_mix': gain((DEPTH, D)),
        'norm_x': gain((DEPTH, D)),
        'norm_mem': gain((DEPTH, D)),
        'w_xq': w((DEPTH, D, X_HEADS * X_HEAD_DIM), D),
        'w_xkv': w((DEPTH, D, 2 * X_HEADS * X_HEAD_DIM), D),
        'w_xo': w((DEPTH, X_HEADS * X_HEAD_DIM, D), X_HEADS * X_HEAD_DIM),
        'norm_mlp': gain((DEPTH, D)),
        'w_mlp_in': w((DEPTH, D, D_FF), D),
        'w_mlp_out': w((DEPTH, D_FF, D), D_FF),
        'a_w_in': w((N_A, D, A_IN), D),
        'a_w_out': w((N_A, A_HEADS * A_HEAD_DIM, D), A_HEADS * A_HEAD_DIM),
        'b_w_in': w((N_B, D, B_IN), D),
        'b_q_norm': gain((N_B, B_HEAD_DIM)),
        'b_k_norm': gain((N_B, B_HEAD_DIM)),
        'b_w_out': w((N_B, B_HEADS * B_HEAD_DIM, D), B_HEADS * B_HEAD_DIM),
        'c_w_in': w((N_C, D, C_IN), D),
        'c_lambda_q1': small((N_C, C_DIM)),
        'c_lambda_k1': small((N_C, C_DIM)),
        'c_lambda_q2': small((N_C, C_DIM)),
        'c_lambda_k2': small((N_C, C_DIM)),
        'c_sub_norm': gain((N_C, 2 * C_DIM)),
        'c_w_out': w((N_C, C_HEADS * 2 * C_DIM, D), C_HEADS * 2 * C_DIM),
        'd_w_in': w((N_D, D, D_IN), D),
        'd_q_norm': gain((N_D, D_Q_RANK)),
        'd_kv_norm': gain((N_D, D_KV_RANK)),
        'd_w_uq': w((N_D, D_Q_RANK, D_HEADS * (D_NOPE + D_ROPE)), D_Q_RANK),
        'd_w_ukv': w((N_D, D_KV_RANK, D_HEADS * (D_NOPE + D_V)), D_KV_RANK),
        'd_w_out': w((N_D, D_HEADS * D_V, D), D_HEADS * D_V),
        'final_norm': gain((D,)),
    }


def reference(x_prompt, x_sample, mem_prompt, mem_sample, norm_mix, norm_x, norm_mem, w_xq, w_xkv,
              w_xo, norm_mlp, w_mlp_in, w_mlp_out, a_w_in, a_w_out, b_w_in, b_q_norm, b_k_norm,
              b_w_out, c_w_in, c_lambda_q1, c_lambda_k1, c_lambda_q2, c_lambda_k2, c_sub_norm,
              c_w_out, d_w_in, d_q_norm, d_kv_norm, d_w_uq, d_w_ukv, d_w_out, final_norm):
    p = dict(norm_mix=norm_mix, norm_x=norm_x, norm_mem=norm_mem, w_xq=w_xq, w_xkv=w_xkv,
             w_xo=w_xo, norm_mlp=norm_mlp, w_mlp_in=w_mlp_in, w_mlp_out=w_mlp_out,
             a_w_in=a_w_in, a_w_out=a_w_out, b_w_in=b_w_in, b_q_norm=b_q_norm,
             b_k_norm=b_k_norm, b_w_out=b_w_out, c_w_in=c_w_in, c_lambda_q1=c_lambda_q1,
             c_lambda_k1=c_lambda_k1, c_lambda_q2=c_lambda_q2, c_lambda_k2=c_lambda_k2,
             c_sub_norm=c_sub_norm, c_w_out=c_w_out, d_w_in=d_w_in, d_q_norm=d_q_norm,
             d_kv_norm=d_kv_norm, d_w_uq=d_w_uq, d_w_ukv=d_w_ukv, d_w_out=d_w_out,
             final_norm=final_norm)
    y_prompt = run_trunk(x_prompt, mem_prompt, p)
    y_sample = run_trunk(x_sample, mem_sample, p)
    return (y_prompt, y_sample)
```

```cpp
#include <hip/hip_runtime.h>
#include <hip/hip_cooperative_groups.h>
#include <cstdio>
#include <cstdint>
#include <cmath>
namespace cg = cooperative_groups;
#ifndef MK_MULTI
#define MK_MULTI 0
#endif
#ifndef PROBE_ATT2
#define PROBE_ATT2 0
#endif
#ifndef PROBE_NORM2
#define PROBE_NORM2 0
#endif
#ifndef PROBE_GST2
#define PROBE_GST2 0
#endif
#ifndef PROBE_REP
#define PROBE_REP 1
#endif
#ifndef PROBE_PREP2
#define PROBE_PREP2 0
#endif
namespace pg8 {
#define PG8_LAS __attribute__((address_space(3)))
#define PG8_GAS __attribute__((address_space(1)))
typedef unsigned short bf16_t;
typedef short bf16x8 __attribute__((ext_vector_type(8)));
typedef float f32x4 __attribute__((ext_vector_type(4)));
typedef unsigned u32x4 __attribute__((ext_vector_type(4)));
constexpr int BM = 256, BK = 64, HALF = 128, HTB = HALF * BK * 2  , STAGE_BYTES = 8 * HTB, NXCD = 8, WGM = 8;

__host__ __device__ __forceinline__ int lds_byte(int r, int c) { const int st = (r >> 4) * 2 + (c >> 5), rr = r & 15, cc = c & 31, ob = rr * 64 + cc * 2; return st * 1024 + (ob ^ (((ob >> 9) & 1) << 5)); }
__host__ __device__ __forceinline__ void stage_rc(int b, int& R, int& C) { const int st = b / 1024, sb = b % 1024, swz = sb ^ (((sb >> 9) & 1) << 5); R = (st >> 1) * 16 + swz / 64; C = (st & 1) * 32 + (swz % 64) / 2; }
__host__ __device__ __forceinline__ int perm32(int rho) { const int n = rho >> 4, i = rho & 15; return 8 * (i >> 2) + 4 * n + (i & 3); }

struct Unit { int pm, pn; };
struct Gemm { const bf16_t* A; const bf16_t* Bt; int M, N, K, lda, ldb; };

struct StaticOrder {
    int nM, nN, nwg, G, c;
    __host__ __device__ void init(int M, int N, int G_, int c_) { nM = M / BM; nN = N / BM; nwg = nM * nN; G = G_; c = c_; }
    __host__ __device__ bool next(int i, Unit& u) const {
        const long L = (long)i * G + c; if (L >= nwg) return false;
        int wgid = (int)L; { const int q = nwg / NXCD, r = nwg % NXCD, xcd = wgid % NXCD, off = wgid / NXCD; wgid = (xcd < r ? xcd * (q + 1) : r * (q + 1) + (xcd - r) * q) + off; }
        const int nig = WGM * nN, gid = wgid / nig, fm = gid * WGM, gsz = (nM - fm) < WGM ? (nM - fm) : WGM;
        u.pm = fm + ((wgid % nig) % gsz); u.pn = (wgid % nig) / gsz; return true;
    }
    __device__ __forceinline__ void a_ready(const Unit&) const {}
    __device__ __forceinline__ void done(const Unit&) const {}
};

__device__ __forceinline__ unsigned cvt_pk_bf16(float lo, float hi) { unsigned r; asm volatile("v_cvt_pk_bf16_f32 %0, %1, %2" : "=v"(r) : "v"(lo), "v"(hi)); return r; }
typedef float f32x2 __attribute__((ext_vector_type(2)));
template <int ACT  > struct EpiStore {
    static constexpr bool PERM = true, AFTER_DRAIN = false;
    bf16_t* O; int ldc; const unsigned long long* ss;
    int mode; const float* tab; int smask, rmod, rlim;
    __device__ __forceinline__ void operator()(const f32x4 (&acc)[2][2][4][2], const Unit& u, int wr, int wc, int fr, int fq) const {
        const int row0 = u.pm * BM + wr * 64 + fr; const int col0 = u.pn * BM + wc * 32 + 8 * fq;
        float rsv[2][4];
        if (ss) { unsigned long long sv[2][4];
#pragma unroll
            for (int ai = 0; ai < 2; ++ai)
#pragma unroll
                for (int m = 0; m < 4; ++m) sv[ai][m] = ((const PG8_GAS unsigned long long*)ss)[row0 + ai * HALF + m * 16];
#pragma unroll
            for (int ai = 0; ai < 2; ++ai)
#pragma unroll
                for (int m = 0; m < 4; ++m) rsv[ai][m] = 1.0f / sqrtf((float)sv[ai][m] * (1.0f / (1024.0f * 1048576.0f)) + 1e-6f);
        } else {
#pragma unroll
            for (int ai = 0; ai < 2; ++ai)
#pragma unroll
                for (int m = 0; m < 4; ++m) rsv[ai][m] = 1.0f; }
#pragma unroll
        for (int ai = 0; ai < 2; ++ai)
#pragma unroll
            for (int m = 0; m < 4; ++m) { PG8_GAS bf16_t* rowp = (PG8_GAS bf16_t*)O + (size_t)(row0 + ai * HALF + m * 16) * ldc + col0;
                const float rs = rsv[ai][m];
#pragma unroll
                for (int bj = 0; bj < 2; ++bj) { f32x4 v0 = acc[ai][bj][m][0] * rs, v1 = acc[ai][bj][m][1] * rs;
                    if (mode != 0) {
                        const bool span = mode == 1 ? ((wc & 1) == 0 && (u.pn % rmod) < rlim) : (((u.pn * 8 + bj * 4 + wc) % 3) == 2);
                        if (span) {
                            const int pos = (row0 + ai * HALF + m * 16) & smask;
                            const PG8_GAS f32x4* t4 = (const PG8_GAS f32x4*)((const PG8_GAS float*)tab + (mode == 1 ? (size_t)pos * 16 : (size_t)pos * 32 + 16 * (fq & 1)));
                            const int dist = mode == 1 ? 16 : 32; const bool part = mode == 1 ? fq < 2 : true; const bool firsth = mode == 1 ? fq == 0 : fq < 2;
                            const f32x4 c0 = t4[0], c1 = t4[1], c2 = t4[2], c3 = t4[3];
                            f32x4 o0, o1;
#pragma unroll
                            for (int e = 0; e < 4; ++e) { o0[e] = __shfl_xor(v0[e], dist); o1[e] = __shfl_xor(v1[e], dist); }
                            if (part) { const float sg = firsth ? -1.0f : 1.0f;
                                v0[0] = v0[0] * c0.x + sg * o0[0] * c0.y; v0[1] = v0[1] * c0.z + sg * o0[1] * c0.w; v0[2] = v0[2] * c1.x + sg * o0[2] * c1.y; v0[3] = v0[3] * c1.z + sg * o0[3] * c1.w;
                                v1[0] = v1[0] * c2.x + sg * o1[0] * c2.y; v1[1] = v1[1] * c2.z + sg * o1[1] * c2.w; v1[2] = v1[2] * c3.x + sg * o1[2] * c3.y; v1[3] = v1[3] * c3.z + sg * o1[3] * c3.w; }
                        }
                    }
                    if (ACT == 1) {
#pragma unroll
                        for (int e = 0; e < 4; ++e) { float a = v0[e] > 0.f ? v0[e] : 0.f; v0[e] = a * a; float b = v1[e] > 0.f ? v1[e] : 0.f; v1[e] = b * b; } }
                    u32x4 w; w.x = cvt_pk_bf16(v0[0], v0[1]); w.y = cvt_pk_bf16(v0[2], v0[3]); w.z = cvt_pk_bf16(v1[0], v1[1]); w.w = cvt_pk_bf16(v1[2], v1[3]);
                    *(PG8_GAS u32x4*)(rowp + bj * HALF) = w; } }
    }
};
struct EpiResid {
    static constexpr bool PERM = true, AFTER_DRAIN = false;
    bf16_t* XB; int ldc; unsigned long long* ss;
    __device__ __forceinline__ void operator()(const f32x4 (&acc)[2][2][4][2], const Unit& u, int wr, int wc, int fr, int fq) const {
        const int row0 = u.pm * BM + wr * 64 + fr; const int col0 = u.pn * BM + wc * 32 + 8 * fq;
        PG8_GAS bf16_t* XBg = (PG8_GAS bf16_t*)XB; PG8_GAS unsigned long long* ssg = (PG8_GAS unsigned long long*)ss;
        u32x4 pre[2][4][2];
#pragma unroll
        for (int ai = 0; ai < 2; ++ai)
#pragma unroll
            for (int m = 0; m < 4; ++m)
#pragma unroll
                for (int bj = 0; bj < 2; ++bj) pre[ai][m][bj] = *(const PG8_GAS u32x4*)(XBg + (size_t)(row0 + ai * HALF + m * 16) * ldc + col0 + bj * HALF);
#pragma unroll
        for (int ai = 0; ai < 2; ++ai)
#pragma unroll
            for (int m = 0; m < 4; ++m) { const int row = row0 + ai * HALF + m * 16; PG8_GAS bf16_t* rowb = XBg + (size_t)row * ldc + col0;
                float sq = 0.f;
#pragma unroll
                for (int bj = 0; bj < 2; ++bj) { const u32x4 o = pre[ai][m][bj]; const f32x4 c0 = acc[ai][bj][m][0], c1 = acc[ai][bj][m][1];
                    u32x4 w; w.x = cvt_pk_bf16(__uint_as_float(o.x << 16) + c0[0], __uint_as_float(o.x & 0xffff0000u) + c0[1]); w.y = cvt_pk_bf16(__uint_as_float(o.y << 16) + c0[2], __uint_as_float(o.y & 0xffff0000u) + c0[3]);
                    w.z = cvt_pk_bf16(__uint_as_float(o.z << 16) + c1[0], __uint_as_float(o.z & 0xffff0000u) + c1[1]); w.w = cvt_pk_bf16(__uint_as_float(o.w << 16) + c1[2], __uint_as_float(o.w & 0xffff0000u) + c1[3]);
                    *(PG8_GAS u32x4*)(rowb + bj * HALF) = w;
                    const float a0 = __uint_as_float(w.x << 16), a1 = __uint_as_float(w.x & 0xffff0000u), a2 = __uint_as_float(w.y << 16), a3 = __uint_as_float(w.y & 0xffff0000u);
                    const float b0 = __uint_as_float(w.z << 16), b1 = __uint_as_float(w.z & 0xffff0000u), b2 = __uint_as_float(w.w << 16), b3 = __uint_as_float(w.w & 0xffff0000u);
                    sq += (a0 * a0 + a1 * a1) + (a2 * a2 + a3 * a3) + (b0 * b0 + b1 * b1) + (b2 * b2 + b3 * b3); }
                sq += __shfl_xor(sq, 16); sq += __shfl_xor(sq, 32);
                if (fq == 0) __hip_atomic_fetch_add(ssg + row, (unsigned long long)(sq * 1048576.0f + 0.5f), __ATOMIC_RELAXED, __HIP_MEMORY_SCOPE_AGENT); }
    }
};

template <class Epi, class Sched, bool ALIGN_EPI = false, bool SP2 = false>
__device__ __forceinline__ void gemm_phase(PG8_LAS unsigned char* lds, const Gemm g, const Sched& S, const Epi& E) {
    const int tid = threadIdx.x, wid = __builtin_amdgcn_readfirstlane(tid >> 6), lane = tid & 63, wr = wid >> 2, wc = wid & 3, fr = lane & 15, fq = lane >> 4;
    const int K = g.K, nt = K / BK;
    unsigned voffA[2], voffB[2];
#pragma unroll
    for (int i = 0; i < 2; ++i) { int R, C; stage_rc(tid * 16 + i * 8192, R, C); const int Rb = Epi::PERM ? ((R & ~31) + perm32(R & 31)) : R;
        voffA[i] = (unsigned)(R * g.lda + C) * 2u; voffB[i] = (unsigned)(Rb * g.ldb + C) * 2u; }
    const size_t kstep = (size_t)(BK * 2);
    const size_t hstepA = (size_t)HALF * g.lda * 2, hstepB = (size_t)HALF * g.ldb * 2;
    const size_t tstepA = 2 * hstepA, tstepB = 2 * hstepB;
    const unsigned ldsw = (unsigned)wid * 1024u;
    const int aoff = lds_byte(wr * 64 + fr, fq * 8), boff = lds_byte(wc * 32 + fr, fq * 8);
#define PG8_SA(b, h) (((b) * 2 + (h)) * HTB)
#define PG8_SB(b, h) ((4 + (b) * 2 + (h)) * HTB)
#define PG8_STAGE(bufoff, gbase, voff) do { _Pragma("unroll") for (int _i = 0; _i < 2; ++_i) \
        __builtin_amdgcn_global_load_lds((const unsigned*)((const char*)(gbase) + (voff)[_i]), (PG8_LAS unsigned*)(lds + (bufoff) + ldsw + _i * 8192), 16, 0, 0); } while (0)
#define PG8_LDA(dst, b, h) do { _Pragma("unroll") for (int m = 0; m < 4; ++m) _Pragma("unroll") for (int k = 0; k < 2; ++k) dst[m][k] = *(const PG8_LAS bf16x8*)(lds + PG8_SA(b, h) + aoff + m * 2048 + k * 1024); } while (0)
#define PG8_LDB(dst, b, h) do { _Pragma("unroll") for (int n = 0; n < 2; ++n) _Pragma("unroll") for (int k = 0; k < 2; ++k) dst[n][k] = *(const PG8_LAS bf16x8*)(lds + PG8_SB(b, h) + boff + n * 2048 + k * 1024); } while (0)
#define PG8_MMA(ai, bj, At, Bt) do { __builtin_amdgcn_s_setprio(1); _Pragma("unroll") for (int m = 0; m < 4; ++m) _Pragma("unroll") for (int n = 0; n < 2; ++n) _Pragma("unroll") for (int k = 0; k < 2; ++k) \
        acc[ai][bj][m][n] = __builtin_amdgcn_mfma_f32_16x16x32_bf16(Bt[n][k], At[m][k], acc[ai][bj][m][n], 0, 0, 0); __builtin_amdgcn_s_setprio(0); } while (0)
#define PG8_WAIT_V(n) asm volatile("s_waitcnt vmcnt(" #n ")" ::: "memory")
#define PG8_WAIT_L(n) asm volatile("s_waitcnt lgkmcnt(" #n ")" ::: "memory")
#define PG8_BAR __builtin_amdgcn_s_barrier()
#define PG8_SCHED __builtin_amdgcn_sched_barrier(0)
    Unit cur, nxt; int ui = 0;
    if (!S.next(0, cur)) return;
    f32x4 acc[2][2][4][2];
#pragma unroll
    for (int a = 0; a < 2; ++a)
#pragma unroll
        for (int b = 0; b < 2; ++b)
#pragma unroll
            for (int m = 0; m < 4; ++m)
#pragma unroll
                for (int n = 0; n < 2; ++n) acc[a][b][m][n] = (f32x4){0.f, 0.f, 0.f, 0.f};
    bf16x8 At[4][2], B0[2][2], B1[2][2];
    const char* cA = (const char*)g.A + (size_t)cur.pm * tstepA; const char* cB = (const char*)g.Bt + (size_t)cur.pn * tstepB;
    S.a_ready(cur);
    if constexpr (SP2) {
        PG8_STAGE(PG8_SB(0, 0), cB, voffB); PG8_STAGE(PG8_SB(0, 1), cB + hstepB, voffB); PG8_STAGE(PG8_SA(0, 0), cA, voffA); PG8_STAGE(PG8_SA(0, 1), cA + hstepA, voffA);
        if (wr == 1) PG8_BAR;
        PG8_WAIT_V(2); PG8_BAR;
        PG8_STAGE(PG8_SB(1, 0), cB + kstep, voffB); PG8_STAGE(PG8_SA(1, 0), cA + kstep, voffA); PG8_STAGE(PG8_SB(1, 1), cB + hstepB + kstep, voffB);
        PG8_WAIT_V(6); PG8_BAR;
    } else {
        PG8_STAGE(PG8_SB(0, 0), cB, voffB); PG8_STAGE(PG8_SA(0, 0), cA, voffA); PG8_STAGE(PG8_SB(0, 1), cB + hstepB, voffB); PG8_STAGE(PG8_SA(0, 1), cA + hstepA, voffA);
        if (wr == 1) PG8_BAR;
        PG8_WAIT_V(4); PG8_BAR;
        PG8_STAGE(PG8_SB(1, 0), cB + kstep, voffB); PG8_STAGE(PG8_SA(1, 0), cA + kstep, voffA); PG8_STAGE(PG8_SB(1, 1), cB + hstepB + kstep, voffB);
        PG8_WAIT_V(6); PG8_BAR;
    }
    for (;;) {
        const bool has_next = S.next(ui + 1, nxt);
        const char* nA = has_next ? (const char*)g.A + (size_t)nxt.pm * tstepA : cA; const char* nB = has_next ? (const char*)g.Bt + (size_t)nxt.pn * tstepB : cB;
        for (int t = 0; t < nt; t += 2) {
            const bool last = (t == nt - 2);
            const char* a1 = cA + (size_t)(t + 1) * kstep;
            const char* a2 = last ? nA : cA + (size_t)(t + 2) * kstep; const char* b2 = last ? nB : cB + (size_t)(t + 2) * kstep;
            const char* a3 = a2 + kstep; const char* b3 = b2 + kstep;
            if (last && has_next) S.a_ready(nxt);
            if constexpr (SP2) {
            PG8_LDB(B0, 0, 0); PG8_LDB(B1, 0, 1); PG8_SCHED; PG8_LDA(At, 0, 0); PG8_STAGE(PG8_SA(1, 1), a1 + hstepA, voffA);
            PG8_WAIT_V(8); PG8_WAIT_L(0); PG8_BAR; PG8_MMA(0, 0, At, B0); PG8_MMA(0, 1, At, B1); PG8_BAR; PG8_SCHED;
            PG8_LDA(At, 0, 1); PG8_STAGE(PG8_SB(0, 0), b2, voffB); PG8_STAGE(PG8_SB(0, 1), b2 + hstepB, voffB); PG8_STAGE(PG8_SA(0, 0), a2, voffA);
            PG8_WAIT_V(8); PG8_WAIT_L(0); PG8_BAR; PG8_MMA(1, 0, At, B0); PG8_MMA(1, 1, At, B1); PG8_BAR; PG8_SCHED;
            PG8_LDB(B0, 1, 0); PG8_LDB(B1, 1, 1); PG8_SCHED; PG8_LDA(At, 1, 0); PG8_STAGE(PG8_SA(0, 1), a2 + hstepA, voffA);
            PG8_WAIT_V(8); PG8_WAIT_L(0); PG8_BAR; PG8_MMA(0, 0, At, B0); PG8_MMA(0, 1, At, B1); PG8_BAR; PG8_SCHED;
            PG8_LDA(At, 1, 1); PG8_STAGE(PG8_SB(1, 0), b3, voffB); PG8_STAGE(PG8_SB(1, 1), b3 + hstepB, voffB); PG8_STAGE(PG8_SA(1, 0), a3, voffA);
            PG8_WAIT_V(8); PG8_WAIT_L(0); PG8_BAR; PG8_MMA(1, 0, At, B0); PG8_MMA(1, 1, At, B1); PG8_BAR; PG8_SCHED;
            } else {
            PG8_LDB(B0, 0, 0); PG8_SCHED; PG8_LDA(At, 0, 0); PG8_STAGE(PG8_SA(1, 1), a1 + hstepA, voffA);
            PG8_WAIT_L(8); PG8_BAR; PG8_WAIT_L(0); PG8_MMA(0, 0, At, B0); PG8_BAR; PG8_SCHED;
            PG8_LDB(B1, 0, 1); PG8_STAGE(PG8_SB(0, 0), b2, voffB);
            PG8_BAR; PG8_WAIT_L(0); PG8_MMA(0, 1, At, B1); PG8_BAR;
            PG8_LDA(At, 0, 1); PG8_STAGE(PG8_SA(0, 0), a2, voffA);
            PG8_BAR; PG8_WAIT_L(0); PG8_MMA(1, 0, At, B0); PG8_BAR; PG8_SCHED;
            PG8_STAGE(PG8_SB(0, 1), b2 + hstepB, voffB);
            PG8_WAIT_V(6); PG8_BAR; PG8_MMA(1, 1, At, B1); PG8_BAR;
            PG8_LDB(B0, 1, 0); PG8_SCHED; PG8_LDA(At, 1, 0); PG8_STAGE(PG8_SA(0, 1), a2 + hstepA, voffA);
            PG8_WAIT_L(8); PG8_BAR; PG8_WAIT_L(0); PG8_MMA(0, 0, At, B0); PG8_BAR; PG8_SCHED;
            PG8_LDB(B1, 1, 1); PG8_STAGE(PG8_SB(1, 0), b3, voffB);
            PG8_BAR; PG8_WAIT_L(0); PG8_MMA(0, 1, At, B1); PG8_BAR;
            PG8_LDA(At, 1, 1); PG8_STAGE(PG8_SA(1, 0), a3, voffA);
            PG8_BAR; PG8_WAIT_L(0); PG8_MMA(1, 0, At, B0); PG8_BAR; PG8_SCHED;
            PG8_STAGE(PG8_SB(1, 1), b3 + hstepB, voffB);
            PG8_WAIT_V(6); PG8_BAR; PG8_MMA(1, 1, At, B1); PG8_BAR;
            }
        }
        if constexpr (ALIGN_EPI) { if (wr == 0) PG8_BAR; }
        if constexpr (!Epi::AFTER_DRAIN) { E(acc, cur, wr, wc, fr, fq); S.done(cur); }
        if (!has_next) break;
#pragma unroll
        for (int a = 0; a < 2; ++a)
#pragma unroll
            for (int b = 0; b < 2; ++b)
#pragma unroll
                for (int m = 0; m < 4; ++m)
#pragma unroll
                    for (int n = 0; n < 2; ++n) acc[a][b][m][n] = (f32x4){0.f, 0.f, 0.f, 0.f};
        cur = nxt; cA = nA; cB = nB; ++ui;
        if constexpr (ALIGN_EPI) { if (wr == 1) PG8_BAR; }
    }
    PG8_WAIT_V(0);
    if constexpr (!ALIGN_EPI) { if (wr == 0) PG8_BAR; }
    PG8_BAR;
    if constexpr (Epi::AFTER_DRAIN) { E.fused(acc, cur, wr, wc, fr, fq, lds, wid, lane); S.done(cur); }
#undef PG8_SA
#undef PG8_SB
#undef PG8_STAGE
#undef PG8_LDA
#undef PG8_LDB
#undef PG8_MMA
#undef PG8_WAIT_V
#undef PG8_WAIT_L
#undef PG8_BAR
#undef PG8_SCHED
}
}
#define LAS __attribute__((address_space(3)))
#define GASA __attribute__((address_space(1)))
typedef unsigned short bf16_t;
typedef short bf16x8 __attribute__((ext_vector_type(8)));
typedef short s16x4 __attribute__((ext_vector_type(4)));
typedef float f32x4 __attribute__((ext_vector_type(4)));
typedef float f32x2 __attribute__((ext_vector_type(2)));
typedef float f32x16 __attribute__((ext_vector_type(16)));
typedef unsigned u32x4 __attribute__((ext_vector_type(4)));
typedef unsigned u32x2 __attribute__((ext_vector_type(2)));
typedef __bf16 bf16x2_t __attribute__((ext_vector_type(2)));
#define DI __device__ __forceinline__
DI unsigned pk2(float lo, float hi) { f32x2 v = {lo, hi}; bf16x2_t b = __builtin_convertvector(v, bf16x2_t); return __builtin_bit_cast(unsigned, b); }
DI float bflo(unsigned w) { return __uint_as_float(w << 16); }
DI float bfhi(unsigned w) { return __uint_as_float(w & 0xffff0000u); }
DI void unpack8(const u32x4 w, float* x) { x[0] = bflo(w.x); x[1] = bfhi(w.x); x[2] = bflo(w.y); x[3] = bfhi(w.y); x[4] = bflo(w.z); x[5] = bfhi(w.z); x[6] = bflo(w.w); x[7] = bfhi(w.w); }
DI u32x4 pack8(const float* x) { u32x4 w; w.x = pk2(x[0], x[1]); w.y = pk2(x[2], x[3]); w.z = pk2(x[4], x[5]); w.w = pk2(x[6], x[7]); return w; }
DI float wave_sum(float v) {
#pragma unroll
    for (int o = 1; o < 64; o <<= 1) v += __shfl_xor(v, o);
    return v;
}
constexpr float NORM_EPS = 1e-6f;
constexpr float LOG2E = 1.4426950408889634f;

struct AttnArgs {
    const bf16_t* q; long qs;
    const bf16_t* k; long ks;
    const bf16_t* k2; long k2s;
    const bf16_t* v; long vs;
    bf16_t* o; long os;
    float* lse; long lses;
    int kv_len, q0;
    int nomax;
};
DI int crow(int r, int hi) { return (r & 3) + 8 * (r >> 2) + 4 * hi; }
#define MFMA32(a, b, c) __builtin_amdgcn_mfma_f32_32x32x16_bf16((a), (b), (c), 0, 0, 0)
typedef short v4i16_t __attribute__((ext_vector_type(4)));
DI s16x4 vtr(const LAS unsigned char* p) { return __builtin_bit_cast(s16x4, __builtin_amdgcn_ds_read_tr16_b64_v4i16((LAS v4i16_t*)p)); }

DI void glds16(const void* gsrc, unsigned lds_dst) { unsigned keep;
    asm volatile("s_mov_b32 %0, m0\n\ts_mov_b32 m0, %2\n\ts_nop 0\n\tglobal_load_lds_dwordx4 %1, off\n\ts_mov_b32 m0, %0" : "=&s"(keep) : "v"(gsrc), "s"(lds_dst) : "memory"); }
template <int DQK, int DV, bool BAND>
DI void attn_unit(const AttnArgs& a, LAS unsigned char* lds, int tid) {
    constexpr int NKP = DQK / 8, NVP = DV / 8;
    constexpr int NKI = (NKP + 7) / 8, NVI = NVP / 8;
    constexpr int NLD = NKI + NVI;
    constexpr int ND0 = DQK / 16, NDB = DV / 32, KG = DQK > 96 ? 1 : 4;
    constexpr int KBUF = 0, VBUF = 49152, SCR = 98304;
    const int lane = tid & 63, wid = __builtin_amdgcn_readfirstlane(tid >> 6), r32 = lane & 31, hi = lane >> 5;
    LAS float* scr = (LAS float*)(lds + SCR + wid * 256);
    const unsigned lds0 = (unsigned)(uintptr_t)lds;
    bf16x8 qf[ND0];
    int t_lo = 0, t_hi = a.kv_len >> 6;
    if (BAND) { const int tb = (a.q0 >> 6) - 1; t_lo = tb < 0 ? 0 : tb; const int te = (a.q0 >> 6) + 5; t_hi = te < t_hi ? te : t_hi; }
    const int qw = a.q0 + wid * 32;
#define AT_DMA(t, so_) do { \
    _Pragma("unroll") for (int i_ = 0; i_ < NKI; ++i_) { const int pl_ = (wid + 8 * i_ < NKP) ? wid + 8 * i_ : wid; const long key_ = (long)(t) * 64 + lane; \
        const bf16_t* s_ = (DQK == 96 && pl_ >= 8) ? a.k2 + key_ * a.k2s + (pl_ - 8) * 8 : a.k + key_ * a.ks + pl_ * 8; \
        glds16(s_, (unsigned)__builtin_amdgcn_readfirstlane(lds0 + KBUF + (so_) + pl_ * 1024)); } \
    _Pragma("unroll") for (int i_ = 0; i_ < NVI; ++i_) { const int pc_ = wid + 8 * i_; const long row_ = (long)(t) * 64 + 16 * (pc_ & 3) + (lane >> 2); \
        glds16(a.v + row_ * a.vs + (pc_ >> 2) * 32 + (lane & 3) * 8, (unsigned)__builtin_amdgcn_readfirstlane(lds0 + VBUF + (so_) + pc_ * 1024)); } } while (0)
#define AT_WAITBAR(N) asm volatile("s_waitcnt vmcnt(%0) lgkmcnt(0)\n\ts_barrier" :: "n"(N) : "memory")
#define AT_PV(vs_) do { \
    const LAS unsigned char* vp_ = lds + VBUF + (vs_) + ((lane >> 4) & 1) * 32 + (lane & 3) * 8 + (4 * hi + ((lane & 15) >> 2)) * 64; \
    _Pragma("unroll") for (int ks = 0; ks < 4; ++ks) { \
        _Pragma("unroll") for (int d = 0; d < NDB; ++d) { \
            const s16x4 lo = vtr(vp_ + d * 4096 + ks * 1024), hh = vtr(vp_ + d * 4096 + ks * 1024 + 512); \
            const bf16x8 vf = (bf16x8){lo[0], lo[1], lo[2], lo[3], hh[0], hh[1], hh[2], hh[3]}; \
            o[d] = MFMA32(pa[ks], vf, o[d]); } \
        lacc = MFMA32(pa[ks], ones, lacc); } } while (0)
    if (wid >= 4) __builtin_amdgcn_s_setprio(1);
    f32x16 o[NDB], lacc, negm;
#pragma unroll
    for (int d = 0; d < NDB; ++d)
#pragma unroll
        for (int r = 0; r < 16; ++r) o[d][r] = 0.f;
#pragma unroll
    for (int r = 0; r < 16; ++r) { lacc[r] = 0.f; negm[r] = 0.f; }
    float m_run = 0.f; bool first = true;
    const bf16x8 ones = (bf16x8){(short)0x3F80, (short)0x3F80, (short)0x3F80, (short)0x3F80, (short)0x3F80, (short)0x3F80, (short)0x3F80, (short)0x3F80};
    if (BAND) {
        for (int t = t_lo; t < t_hi; ++t) AT_DMA(t, (t - t_lo) * 8192);
    } else {
        AT_DMA(t_lo, 0);
        if (t_lo + 1 < t_hi) AT_DMA(t_lo + 1, 16384);
    }
    { const GASA bf16_t* qrow = (const GASA bf16_t*)a.q + (long)(wid * 32 + r32) * a.qs;
#pragma unroll
      for (int d0 = 0; d0 < ND0; ++d0) qf[d0] = *(const GASA bf16x8*)(qrow + d0 * 16 + hi * 8); }
#pragma unroll
    for (int d0 = 0; d0 < ND0; ++d0) asm volatile("" : "+v"(qf[d0]));
    asm volatile("s_waitcnt vmcnt(0)" ::: "memory");
    if (BAND) AT_WAITBAR(0);
    int vcur = 0;
    bf16x8 pa[4];
    for (int t = t_lo; t < t_hi; ++t) {
        int vnext = 0;
        if (BAND) { vcur = (t - t_lo) * 8192; }
        else {
            if (t + 1 < t_hi) AT_WAITBAR(NLD); else AT_WAITBAR(0);
            vnext = vcur == 32768 ? 0 : vcur + 16384; const int vnn = vnext == 32768 ? 0 : vnext + 16384;
            if (t + 2 < t_hi) AT_DMA(t + 2, vnn);
        }
        bool active = true;
        if (BAND) active = (64 * t + 63 >= qw - 64) && (64 * t <= qw + 95);
        if (active) {
            f32x16 p0, p1;
            const LAS unsigned char* kb = lds + KBUF + vcur + hi * 1024 + r32 * 16;
#pragma unroll
            for (int dg = 0; dg < ND0; dg += KG) {
                bf16x8 kf0[KG], kf1[KG];
#pragma unroll
                for (int j = 0; j < KG; ++j) if (dg + j < ND0) { kf0[j] = *(const LAS bf16x8*)(kb + (dg + j) * 2048); kf1[j] = *(const LAS bf16x8*)(kb + (dg + j) * 2048 + 512); }
                __builtin_amdgcn_sched_barrier(0);
#pragma unroll
                for (int j = 0; j < KG; ++j) if (dg + j < ND0) {
                    if (dg + j == 0) { p0 = MFMA32(kf0[j], qf[0], negm); p1 = MFMA32(kf1[j], qf[0], negm); }
                    else { p0 = MFMA32(kf0[j], qf[dg + j], p0); p1 = MFMA32(kf1[j], qf[dg + j], p1); }
                }
            }
            s16x4 vlo[8], vhi[8];
            if (NDB <= 2) { const LAS unsigned char* vp_ = lds + VBUF + vcur + ((lane >> 4) & 1) * 32 + (lane & 3) * 8 + (4 * hi + ((lane & 15) >> 2)) * 64;
#pragma unroll
              for (int d = 0; d < 2; ++d)
#pragma unroll
                  for (int ks = 0; ks < 4; ++ks) { vlo[d * 4 + ks] = vtr(vp_ + d * 4096 + ks * 1024); vhi[d * 4 + ks] = vtr(vp_ + d * 4096 + ks * 1024 + 512); } }
            __builtin_amdgcn_sched_barrier(0);
            if (BAND) { const int qi = qw + r32; const int kb0 = 64 * t + 4 * hi;
#pragma unroll
                for (int r = 0; r < 16; ++r) { const int kv = kb0 + (r & 3) + 8 * (r >> 2); int d = qi - kv; d = d < 0 ? -d : d; if (d > 64) p0[r] = -1e30f; int d2 = qi - kv - 32; d2 = d2 < 0 ? -d2 : d2; if (d2 > 64) p1[r] = -1e30f; } }
            if (!a.nomax) {
            float mx = fmaxf(p0[0], p1[0]);
#pragma unroll
            for (int r = 1; r < 16; ++r) mx = fmaxf(fmaxf(mx, p0[r]), p1[r]);
            { const unsigned mu = __float_as_uint(mx); auto rr = __builtin_amdgcn_permlane32_swap(mu, mu, false, false); mx = fmaxf(__uint_as_float(rr[0]), __uint_as_float(rr[1])); }
            if (first || __any(mx > 8.0f)) {
                const float delta = first ? fmaxf(mx, -1e4f) : fmaxf(mx, 0.f);
                m_run += delta;
#pragma unroll
                for (int r = 0; r < 16; ++r) { p0[r] -= delta; p1[r] -= delta; negm[r] = -m_run; }
                if (!first) {
                    const float alpha = __builtin_amdgcn_exp2f(-delta);
                    if (hi == 0) scr[r32] = alpha;
#pragma unroll
                    for (int g = 0; g < 4; ++g) { const f32x4 al = *(const LAS f32x4*)(scr + 8 * g + 4 * hi);
                        lacc[4 * g] *= al.x; lacc[4 * g + 1] *= al.y; lacc[4 * g + 2] *= al.z; lacc[4 * g + 3] *= al.w;
#pragma unroll
                        for (int d = 0; d < NDB; ++d) { o[d][4 * g] *= al.x; o[d][4 * g + 1] *= al.y; o[d][4 * g + 2] *= al.z; o[d][4 * g + 3] *= al.w; } }
                }
                first = false;
            }
            }
#pragma unroll
            for (int r = 0; r < 16; ++r) { p0[r] = __builtin_amdgcn_exp2f(p0[r]); p1[r] = __builtin_amdgcn_exp2f(p1[r]); }
            { u32x4 w;
              w.x = pk2(p0[0], p0[1]); w.y = pk2(p0[2], p0[3]); w.z = pk2(p0[4], p0[5]); w.w = pk2(p0[6], p0[7]); pa[0] = __builtin_bit_cast(bf16x8, w);
              w.x = pk2(p0[8], p0[9]); w.y = pk2(p0[10], p0[11]); w.z = pk2(p0[12], p0[13]); w.w = pk2(p0[14], p0[15]); pa[1] = __builtin_bit_cast(bf16x8, w);
              w.x = pk2(p1[0], p1[1]); w.y = pk2(p1[2], p1[3]); w.z = pk2(p1[4], p1[5]); w.w = pk2(p1[6], p1[7]); pa[2] = __builtin_bit_cast(bf16x8, w);
              w.x = pk2(p1[8], p1[9]); w.y = pk2(p1[10], p1[11]); w.z = pk2(p1[12], p1[13]); w.w = pk2(p1[14], p1[15]); pa[3] = __builtin_bit_cast(bf16x8, w); }
            if (DQK > 96) { AT_PV(vcur); } else {
                if (NDB > 2) { const LAS unsigned char* vp_ = lds + VBUF + vcur + ((lane >> 4) & 1) * 32 + (lane & 3) * 8 + (4 * hi + ((lane & 15) >> 2)) * 64;
#pragma unroll
                    for (int d = 0; d < 2; ++d)
#pragma unroll
                        for (int ks = 0; ks < 4; ++ks) { vlo[d * 4 + ks] = vtr(vp_ + d * 4096 + ks * 1024); vhi[d * 4 + ks] = vtr(vp_ + d * 4096 + ks * 1024 + 512); }
                    __builtin_amdgcn_sched_barrier(0); }
#pragma unroll
                for (int ks = 0; ks < 4; ++ks) {
#pragma unroll
                    for (int d = 0; d < 2; ++d) { const s16x4 lo = vlo[d * 4 + ks], hh = vhi[d * 4 + ks];
                        const bf16x8 vf = (bf16x8){lo[0], lo[1], lo[2], lo[3], hh[0], hh[1], hh[2], hh[3]}; o[d] = MFMA32(pa[ks], vf, o[d]); }
                    lacc = MFMA32(pa[ks], ones, lacc); }
                if (NDB > 2) {
                    const LAS unsigned char* vp_ = lds + VBUF + vcur + ((lane >> 4) & 1) * 32 + (lane & 3) * 8 + (4 * hi + ((lane & 15) >> 2)) * 64;
#pragma unroll
                    for (int d = 2; d < NDB; ++d)
#pragma unroll
                        for (int ks = 0; ks < 4; ++ks) { vlo[(d - 2) * 4 + ks] = vtr(vp_ + d * 4096 + ks * 1024); vhi[(d - 2) * 4 + ks] = vtr(vp_ + d * 4096 + ks * 1024 + 512); }
                    __builtin_amdgcn_sched_barrier(0);
#pragma unroll
                    for (int ks = 0; ks < 4; ++ks)
#pragma unroll
                        for (int d = 2; d < NDB; ++d) { const s16x4 lo = vlo[(d - 2) * 4 + ks], hh = vhi[(d - 2) * 4 + ks];
                            const bf16x8 vf = (bf16x8){lo[0], lo[1], lo[2], lo[3], hh[0], hh[1], hh[2], hh[3]}; o[d] = MFMA32(pa[ks], vf, o[d]); }
                }
            }
        }
        if (!BAND) vcur = vnext;
    }
    asm volatile("s_waitcnt lgkmcnt(0)\n\ts_barrier" ::: "memory");
    __builtin_amdgcn_s_setprio(0);
    { if (a.lse != nullptr) {
          if (hi == 0) scr[r32] = m_run;
#pragma unroll
          for (int g = 0; g < 4; ++g) { const f32x4 mr = *(const LAS f32x4*)(scr + 8 * g + 4 * hi);
#pragma unroll
              for (int e = 0; e < 4; ++e) if (r32 == 0) ((GASA float*)a.lse)[(long)(wid * 32 + 8 * g + 4 * hi + e) * a.lses] = mr[e] + __builtin_amdgcn_logf(lacc[4 * g + e]); } }
      LAS bf16_t* stg = (LAS bf16_t*)(lds + wid * 8192);
#pragma unroll
      for (int g = 0; g < 4; ++g) {
#pragma unroll
          for (int e = 0; e < 4; ++e) { const int orow = 8 * g + 4 * hi + e; const float rr = __builtin_amdgcn_rcpf(lacc[4 * g + e]);
#pragma unroll
              for (int d = 0; d < NDB; ++d) stg[orow * DV + d * 32 + r32] = (bf16_t)(pk2(o[d][4 * g + e] * rr, 0.f) & 0xffffu); } }
      constexpr int CPR = DV / 8, RPI = 64 / CPR;
#pragma unroll
      for (int i = 0; i < 32 / RPI; ++i) { const int row = i * RPI + lane / CPR, ch = lane % CPR;
          const u32x4 v = *(const LAS u32x4*)(stg + row * DV + ch * 8); *(GASA u32x4*)((GASA bf16_t*)a.o + (long)(wid * 32 + row) * a.os + ch * 8) = v; }
    }
    __syncthreads();
#undef AT_DMA
#undef AT_WAITBAR
#undef AT_PV
}
constexpr int DM = 1024, TC = 16384, NCH = 3, DEPTH = 4, FF = 4096, NTOK = 49152, NMEMROWS = 2560;
constexpr size_t MiB = 1u << 20;
constexpr size_t WL_XQ = 0, WL_XKV = WL_XQ + 512 * 1024, WL_XO = WL_XKV + 1024 * 1024, WL_MI = WL_XO + 1024 * 512, WL_MO = WL_MI + 4096 * 1024, WL_SZ = WL_MO + 1024 * 4096;
constexpr size_t W_A_IN = 4 * WL_SZ, W_A_OUT = W_A_IN + 4608 * 1024, W_B_IN = W_A_OUT + 1024 * 512, W_B_OUT = W_B_IN + 1536 * 1024, W_C_IN = W_B_OUT + 1024 * 1024,
                 W_C_OUT = W_C_IN + 3072 * 1024, W_D_IN = W_C_OUT + 1024 * 1024, W_D_UQ = W_D_IN + 768 * 1024, W_D_UKV = W_D_UQ + 1536 * 384, W_D_OUT = W_D_UKV + 2048 * 256, W_END = W_D_OUT + 1024 * 1024;
constexpr size_t WS_CTL = 0, WS_W = 2 * MiB, WS_TAB = 112 * MiB, WS_MN = 114 * MiB, WS_KVM = 134 * MiB, WS_H = 154 * MiB, WS_AO = 186 * MiB, WS_LSE = 218 * MiB,
                 WS_BIG = 220 * MiB, WS_X2 = 380 * MiB, WS_SS = 396 * MiB, WS_END = 404 * MiB;
constexpr size_t SS_BYTES = (size_t)NCH * 5 * 3 * TC * 8;
static_assert(WS_SS + SS_BYTES <= WS_END, "ss fits");
static_assert(WS_W + W_END * 2 <= WS_TAB, "weights fit");
constexpr size_t TAB_A = WS_TAB, TAB_B = WS_TAB + 512 * 1024, TAB_D = WS_TAB + MiB;
constexpr int LDS_BYTES = 131072 + 4096;

struct Params {
    const float* in[33]; float* out; unsigned char* ws;
    double invfA[8], invfD[16], invfB[16];
    float lam_init, one_minus_li; int step_lo, step_hi;
};

DI void transpose_item(const float* W, int K, int N, bf16_t* WT, LAS float* scr, int item, int lane, int period, int hi_, float scale, const float* gain) {
    const int nblk = N / 32, kb = item / nblk, nb = item % nblk, k0 = 64 * kb, n0 = 32 * nb;
    const __attribute__((address_space(1))) float* Wg = (const __attribute__((address_space(1))) float*)W + (size_t)(k0 + (lane >> 5)) * N + n0 + (lane & 31);
    float wv[32];
#pragma unroll
    for (int i = 0; i < 32; ++i) wv[i] = Wg[(size_t)(2 * i) * N];
#pragma unroll
    for (int i = 0; i < 32; ++i) { const int kk = 2 * i + (lane >> 5); scr[kk * 33 + (lane & 31)] = wv[i] * (gain ? gain[k0 + kk] : 1.0f); }
    const int c = lane & 7;
#pragma unroll
    for (int j = 0; j < 4; ++j) { const int n = (lane >> 3) + 8 * j; const LAS float* s = scr + (8 * c) * 33 + n;
        const float sc = ((n0 + n) % period) < hi_ ? scale : 1.0f;
        u32x4 o; o.x = pk2(s[0 * 33] * sc, s[1 * 33] * sc); o.y = pk2(s[2 * 33] * sc, s[3 * 33] * sc); o.z = pk2(s[4 * 33] * sc, s[5 * 33] * sc); o.w = pk2(s[6 * 33] * sc, s[7 * 33] * sc);
        *(__attribute__((address_space(1))) u32x4*)((__attribute__((address_space(1))) bf16_t*)WT + (size_t)(n0 + n) * K + k0 + 8 * c) = o; }
}
DI void norm_row_bf16(const float* xrow, const float* gain, bf16_t* orow, int lane) {
    const __attribute__((address_space(1))) f32x4* xr = (const __attribute__((address_space(1))) f32x4*)xrow + lane; const __attribute__((address_space(1))) f32x4* gr = (const __attribute__((address_space(1))) f32x4*)gain + lane;
    f32x4 v[4]; float s = 0.f;
#pragma unroll
    for (int j = 0; j < 4; ++j) { v[j] = xr[64 * j]; s += (v[j].x * v[j].x + v[j].y * v[j].y) + (v[j].z * v[j].z + v[j].w * v[j].w); }
    const float rstd = 1.0f / sqrtf(wave_sum(s) * (1.f / DM) + NORM_EPS);
    __attribute__((address_space(1))) u32x2* o8 = (__attribute__((address_space(1))) u32x2*)orow + lane;
#pragma unroll
    for (int j = 0; j < 4; ++j) { const f32x4 g = gr[64 * j]; u32x2 w; w.x = pk2(v[j].x * rstd * g.x, v[j].y * rstd * g.y); w.y = pk2(v[j].z * rstd * g.z, v[j].w * rstd * g.w); o8[64 * j] = w; }
}
DI void start_row(const float* xrow, bf16_t* brow, unsigned long long* ssp, int lane) {
    const __attribute__((address_space(1))) f32x4* xr = (const __attribute__((address_space(1))) f32x4*)xrow + lane; __attribute__((address_space(1))) u32x2* o8 = (__attribute__((address_space(1))) u32x2*)brow + lane;
    float s = 0.f;
    f32x4 vv[4];
#pragma unroll
    for (int j = 0; j < 4; ++j) vv[j] = xr[64 * j];
#pragma unroll
    for (int j = 0; j < 4; ++j) { const f32x4 v = vv[j]; u32x2 w; w.x = pk2(v.x, v.y); w.y = pk2(v.z, v.w); o8[64 * j] = w;
        const float a = bflo(w.x), b = bfhi(w.x), c = bflo(w.y), d = bfhi(w.y); s += (a * a + b * b) + (c * c + d * d); }
    s = wave_sum(s);
    if (lane == 0) *(__attribute__((address_space(1))) unsigned long long*)ssp = (unsigned long long)(s * 1048576.0f + 0.5f);
}
DI void norm_row_f32_inplace(float* xrow, const float* gain, int lane) {
    f32x4* xr = (f32x4*)xrow + lane; const f32x4* gr = (const f32x4*)gain + lane;
    f32x4 v[4]; float s = 0.f;
#pragma unroll
    for (int j = 0; j < 4; ++j) { v[j] = xr[64 * j]; s += (v[j].x * v[j].x + v[j].y * v[j].y) + (v[j].z * v[j].z + v[j].w * v[j].w); }
    const float rstd = 1.0f / sqrtf(wave_sum(s) * (1.f / DM) + NORM_EPS);
#pragma unroll
    for (int j = 0; j < 4; ++j) { const f32x4 g = gr[64 * j]; xr[64 * j] = (f32x4){v[j].x * rstd * g.x, v[j].y * rstd * g.y, v[j].z * rstd * g.z, v[j].w * rstd * g.w}; }
}
DI void final_row(const bf16_t* brow, float* orow, const float* gain, unsigned long long ssv, int lane) {
    const __attribute__((address_space(1))) u32x2* br = (const __attribute__((address_space(1))) u32x2*)brow + lane; __attribute__((address_space(1))) f32x4* orr = (__attribute__((address_space(1))) f32x4*)orow + lane; const __attribute__((address_space(1))) f32x4* gr = (const __attribute__((address_space(1))) f32x4*)gain + lane;
    const float rstd = 1.0f / sqrtf((float)ssv * (1.0f / (1024.0f * 1048576.0f)) + NORM_EPS);
#pragma unroll
    for (int j = 0; j < 4; ++j) { const u32x2 w = br[64 * j]; const f32x4 g = gr[64 * j]; orr[64 * j] = (f32x4){bflo(w.x) * rstd * g.x, bfhi(w.x) * rstd * g.y, bflo(w.y) * rstd * g.z, bfhi(w.y) * rstd * g.w}; }
}
DI f32x2 cs_of(double pos, double invf) { double rev = pos * invf * 0.15915494309189533577; rev -= __builtin_rint(rev); const float r = (float)rev; return (f32x2){__builtin_amdgcn_cosf(r), __builtin_amdgcn_sinf(r)}; }

DI void prep_rope16(bf16_t* X, int ld, int nvec, int grp_stride, int seq_len, const f32x2* tab, int gtid, int gthreads) {
    const int total = TC * nvec;
    for (int idx = gtid; idx < total; idx += gthreads) {
        const int row = idx / nvec, v = idx - row * nvec; const int pos = row % seq_len;
        bf16_t* p = X + (size_t)row * ld + (v >> 4) * grp_stride + (v & 15) * 64;
        const u32x4 w1 = *(const u32x4*)p, w2 = *(const u32x4*)(p + 8);
        float x1[8], x2[8], y1[8], y2[8]; unpack8(w1, x1); unpack8(w2, x2);
        const f32x4* t4 = (const f32x4*)(tab + (size_t)pos * 8);
#pragma unroll
        for (int i = 0; i < 4; ++i) { const f32x4 cs = t4[i];
            y1[2 * i] = x1[2 * i] * cs.x - x2[2 * i] * cs.y; y2[2 * i] = x2[2 * i] * cs.x + x1[2 * i] * cs.y;
            y1[2 * i + 1] = x1[2 * i + 1] * cs.z - x2[2 * i + 1] * cs.w; y2[2 * i + 1] = x2[2 * i + 1] * cs.z + x1[2 * i + 1] * cs.w; }
        *(u32x4*)p = pack8(y1); *(u32x4*)(p + 8) = pack8(y2);
    }
}
DI void prep_b(bf16_t* X, const float* qg, const float* kg, int seq_len, const f32x2* tabB, int gtid, int gthreads) {
    const int total = TC * 20 * 8;
    for (int idx = gtid; idx < total; idx += gthreads) {
        const int j = idx & 7, vi = idx >> 3; const int row = vi / 20, vv = vi - row * 20;
        bf16_t* p = X + (size_t)row * 1536 + (vv < 16 ? vv * 64 : 1024 + (vv - 16) * 64) + j * 8;
        const __attribute__((address_space(1))) float* g = (const __attribute__((address_space(1))) float*)(vv < 16 ? qg : kg) + j * 8;
        float x[8]; unpack8(*(const __attribute__((address_space(1))) u32x4*)p, x);
        float ss = 0.f;
#pragma unroll
        for (int e = 0; e < 8; ++e) ss += x[e] * x[e];
        ss += __shfl_xor(ss, 1); ss += __shfl_xor(ss, 2); ss += __shfl_xor(ss, 4);
        const float rstd = 1.0f / sqrtf(ss * (1.f / 64.f) + NORM_EPS);
        const int t = row % seq_len; const int pos = (j >> 2) ? (t & 63) : (t >> 6); const int jj = j & 3; const bool first = jj < 2;
        const __attribute__((address_space(1))) f32x2* tb = (const __attribute__((address_space(1))) f32x2*)tabB + pos * 16 + 8 * (jj & 1);
        float y[8];
#pragma unroll
        for (int e = 0; e < 8; ++e) { x[e] = x[e] * rstd * g[e] * (vv < 16 ? 0.125f * LOG2E : 1.0f); }
#pragma unroll
        for (int e = 0; e < 8; ++e) { const float other = __shfl_xor(x[e], 2); const f32x2 cs = tb[e]; y[e] = first ? x[e] * cs.x - other * cs.y : x[e] * cs.x + other * cs.y; }
        *(__attribute__((address_space(1))) u32x4*)p = pack8(y);
    }
}
DI void prep_d1(const bf16_t* cmb, bf16_t* cqn, bf16_t* ckvn, bf16_t* kr, const float* qg, const float* kvg, int seq_len, const f32x2* tabD, int gw, int ngw, int lane) {
    for (int row = gw; row < TC; row += ngw) {
        const __attribute__((address_space(1))) bf16_t* src = (const __attribute__((address_space(1))) bf16_t*)cmb + (size_t)row * 768;
        float xa[8], xb[8]; unpack8(*(const __attribute__((address_space(1))) u32x4*)(src + 8 * lane), xa);
        if (lane < 20) unpack8(*(const __attribute__((address_space(1))) u32x4*)(src + 8 * (lane + 64)), xb); else {
#pragma unroll
            for (int e = 0; e < 8; ++e) xb[e] = 0.f; }
        float sa = 0.f, sb = 0.f;
#pragma unroll
        for (int e = 0; e < 8; ++e) { sa += xa[e] * xa[e]; sb += xb[e] * xb[e]; }
        const float sq = wave_sum(lane < 48 ? sa : 0.f), skv = wave_sum((lane >= 48 ? sa : 0.f) + (lane < 16 ? sb : 0.f));
        const float rq = 1.0f / sqrtf(sq * (1.f / 384.f) + NORM_EPS), rkv = 1.0f / sqrtf(skv * (1.f / 256.f) + NORM_EPS);
        float y[8];
        if (lane < 48) {
#pragma unroll
            for (int e = 0; e < 8; ++e) y[e] = xa[e] * rq * qg[8 * lane + e];
            *(__attribute__((address_space(1))) u32x4*)((__attribute__((address_space(1))) bf16_t*)cqn + (size_t)row * 384 + 8 * lane) = pack8(y);
        } else {
#pragma unroll
            for (int e = 0; e < 8; ++e) y[e] = xa[e] * rkv * kvg[8 * (lane - 48) + e];
            *(__attribute__((address_space(1))) u32x4*)((__attribute__((address_space(1))) bf16_t*)ckvn + (size_t)row * 256 + 8 * (lane - 48)) = pack8(y);
        }
        if (lane < 16) {
#pragma unroll
            for (int e = 0; e < 8; ++e) y[e] = xb[e] * rkv * kvg[128 + 8 * lane + e];
            *(__attribute__((address_space(1))) u32x4*)((__attribute__((address_space(1))) bf16_t*)ckvn + (size_t)row * 256 + 128 + 8 * lane) = pack8(y);
        }
        const int pos = row % seq_len; const int jj = (lane - 16) & 3; const bool first = jj < 2;
        const f32x2* tb = tabD + (size_t)pos * 16 + 8 * (jj & 1);
#pragma unroll
        for (int e = 0; e < 8; ++e) { const float other = __shfl_xor(xb[e], 2); const f32x2 cs = tb[e]; y[e] = first ? xb[e] * cs.x - other * cs.y : xb[e] * cs.x + other * cs.y; }
        if (lane >= 16 && lane < 20) *(__attribute__((address_space(1))) u32x4*)((__attribute__((address_space(1))) bf16_t*)kr + (size_t)row * 32 + 8 * jj) = pack8(y);
    }
}
DI void prep_d2(bf16_t* Q, int seq_len, const f32x2* tabD, int gtid, int gthreads) {
    for (int idx = gtid; idx < TC * 16; idx += gthreads) {
        const int row = idx >> 4, h = idx & 15; const int pos = row % seq_len;
        bf16_t* p = Q + (size_t)row * 1536 + h * 96 + 64;
        const f32x2* tb = tabD + (size_t)pos * 16;
#pragma unroll
        for (int half = 0; half < 2; ++half) {
            float x1[8], x2[8], y1[8], y2[8]; unpack8(*(const u32x4*)(p + 8 * half), x1); unpack8(*(const u32x4*)(p + 16 + 8 * half), x2);
#pragma unroll
            for (int e = 0; e < 8; ++e) { const f32x2 cs = tb[8 * half + e]; y1[e] = x1[e] * cs.x - x2[e] * cs.y; y2[e] = x2[e] * cs.x + x1[e] * cs.y; }
            *(u32x4*)(p + 8 * half) = pack8(y1); *(u32x4*)(p + 16 + 8 * half) = pack8(y2);
        }
    }
}
DI void merge_a(const bf16_t* QKV, const float* LSE, bf16_t* AO, int gtid, int gthreads) {
    for (int idx = gtid; idx < TC * 64; idx += gthreads) {
        const int j = idx & 7, h = (idx >> 3) & 7, row = idx >> 6;
        const __attribute__((address_space(1))) float* LSEg = (const __attribute__((address_space(1))) float*)LSE; const float l0 = LSEg[((size_t)0 * TC + row) * 8 + h], l1 = LSEg[((size_t)1 * TC + row) * 8 + h], l2 = LSEg[((size_t)2 * TC + row) * 8 + h];
        const float m = fmaxf(l0, fmaxf(l1, l2));
        float w0 = __builtin_amdgcn_exp2f(l0 - m), w1 = __builtin_amdgcn_exp2f(l1 - m), w2 = __builtin_amdgcn_exp2f(l2 - m);
        const float inv = 1.0f / (w0 + w1 + w2); w0 *= inv; w1 *= inv; w2 *= inv;
        const __attribute__((address_space(1))) bf16_t* p = (const __attribute__((address_space(1))) bf16_t*)QKV + (size_t)row * 4608 + h * 64 + j * 8;
        float a[8], b[8], cc[8], y[8]; unpack8(*(const __attribute__((address_space(1))) u32x4*)p, a); unpack8(*(const __attribute__((address_space(1))) u32x4*)(p + 1536), b); unpack8(*(const __attribute__((address_space(1))) u32x4*)(p + 3072), cc);
#pragma unroll
        for (int e = 0; e < 8; ++e) y[e] = w0 * a[e] + w1 * b[e] + w2 * cc[e];
        *(__attribute__((address_space(1))) u32x4*)((__attribute__((address_space(1))) bf16_t*)AO + (size_t)row * 512 + h * 64 + j * 8) = pack8(y);
    }
}
DI void combine_c(const bf16_t* OC, bf16_t* AO, const float* sub_gain, float lam, float oml, int gtid, int gthreads) {
    for (int idx = gtid; idx < TC * 128; idx += gthreads) {
        const int j = idx & 15, h = (idx >> 4) & 7, row = idx >> 7;
        const __attribute__((address_space(1))) bf16_t* p = (const __attribute__((address_space(1))) bf16_t*)OC + (size_t)row * 2048 + h * 256 + j * 8;
        float a[8], b[8], y[8]; unpack8(*(const __attribute__((address_space(1))) u32x4*)p, a); unpack8(*(const __attribute__((address_space(1))) u32x4*)(p + 128), b);
        float ss = 0.f;
#pragma unroll
        for (int e = 0; e < 8; ++e) { a[e] = a[e] - lam * b[e]; ss += a[e] * a[e]; }
        ss += __shfl_xor(ss, 1); ss += __shfl_xor(ss, 2); ss += __shfl_xor(ss, 4); ss += __shfl_xor(ss, 8);
        const float rstd = 1.0f / sqrtf(ss * (1.f / 128.f) + NORM_EPS) * oml;
#pragma unroll
        for (int e = 0; e < 8; ++e) y[e] = a[e] * rstd * sub_gain[8 * j + e];
        *(__attribute__((address_space(1))) u32x4*)((__attribute__((address_space(1))) bf16_t*)AO + (size_t)row * 1024 + h * 128 + j * 8) = pack8(y);
    }
}
#define XB_TMO      128
#define XB_XCNT(j)  (256  + 64 * (j))
#define XB_XSUB(j)  (1280 + 64 * (j))
#define XB_XGEN(j)  (2304 + 64 * (j))
#define XB_TOP      3328
#define XB_TOPGEN   3392
#define XCD_BAR_WORDS 3456
#define XB_SPIN_CAP (1u << 18)

__device__ __forceinline__ unsigned xb_ld(unsigned* p)              { return __hip_atomic_load(p, __ATOMIC_RELAXED, __HIP_MEMORY_SCOPE_AGENT); }
__device__ __forceinline__ unsigned xb_add(unsigned* p, unsigned v) { return __hip_atomic_fetch_add(p, v, __ATOMIC_RELAXED, __HIP_MEMORY_SCOPE_AGENT); }
__device__ __forceinline__ unsigned xb_xcc_id() { return (unsigned)__builtin_amdgcn_s_getreg((3 << 11) | 20) & 0xFu; }
#define XB_SPIN(cond, bar) do { unsigned _sp = 0; while (cond) { __builtin_amdgcn_s_sleep(1); \
    if ((++_sp & 255u) == 0u) { if (xb_ld(&(bar)[XB_TMO])) break; if (_sp > XB_SPIN_CAP) { atomicAdd(&(bar)[XB_TMO], 1u); break; } } } } while (0)

struct XcdBarrier {
    unsigned* bar; unsigned x;
    volatile LAS unsigned* st;
};

__device__ __forceinline__ XcdBarrier xcd_barrier_post(unsigned* bar, volatile LAS unsigned* st) {
    XcdBarrier b; b.bar = bar; b.x = xb_xcc_id(); b.st = st;
    if (threadIdx.x == 0) (void)xb_add(&bar[XB_XCNT(b.x)], 1u);
    return b;
}
__device__ __forceinline__ void xcd_barrier_complete(unsigned* bar, unsigned x, unsigned& nloc, unsigned& nx) {
    const unsigned G = gridDim.x * gridDim.y * gridDim.z;
    unsigned sum, cnt, mine, sp = 0u;
    for (;;) {
        sum = 0u; cnt = 0u; mine = 0u;
#pragma unroll
        for (unsigned j = 0; j < 16; ++j) { const unsigned c = xb_ld(&bar[XB_XCNT(j)]); sum += c; cnt += (c > 0u) ? 1u : 0u; mine = (j == x) ? c : mine; }
        if (sum == G) break;
        __builtin_amdgcn_s_sleep(1);
        if ((++sp & 255u) == 0u) { if (xb_ld(&bar[XB_TMO])) break; if (sp > XB_SPIN_CAP) { atomicAdd(&bar[XB_TMO], 1u); break; } }
    }
    nloc = mine > 0u ? mine : 1u; nx = cnt > 0u ? cnt : 1u;
}

__device__ __forceinline__ void xcd_barrier(const XcdBarrier& b) {
    asm volatile("s_waitcnt vmcnt(0)" ::: "memory");
    __syncthreads();
    if (threadIdx.x == 0) {
        unsigned* bar = b.bar;
        __builtin_amdgcn_s_waitcnt(0);
        unsigned nloc = b.st[0], nx = b.st[1];
        if (nloc == 0u) { xcd_barrier_complete(bar, b.x, nloc, nx); b.st[0] = nloc; b.st[1] = nx; }
        const unsigned old = xb_add(&bar[XB_XSUB(b.x)], 1u);
        const unsigned gen = old / nloc;
        if (old + 1u == (gen + 1u) * nloc) {
            __builtin_amdgcn_fence(__ATOMIC_RELEASE, "agent");
            asm volatile("s_waitcnt vmcnt(0)" ::: "memory");
            const unsigned og = xb_add(&bar[XB_TOP], 1u);
            const unsigned tg = og / nx;
            if (og + 1u == (tg + 1u) * nx) xb_add(&bar[XB_TOPGEN], 1u);
            else XB_SPIN(xb_ld(&bar[XB_TOPGEN]) == tg, bar);
            __builtin_amdgcn_fence(__ATOMIC_ACQUIRE, "agent");
            xb_add(&bar[XB_XGEN(b.x)], 1u);
            asm volatile("s_waitcnt vmcnt(0)" ::: "memory");
        } else {
            XB_SPIN(xb_ld(&bar[XB_XGEN(b.x)]) == gen, bar);
            __builtin_amdgcn_fence(__ATOMIC_ACQUIRE, "agent");
            asm volatile("s_waitcnt vmcnt(0)" ::: "memory");
        }
    }
    __syncthreads();
}
#define GASP __attribute__((address_space(1)))
__global__ void __launch_bounds__(512, 2) mega_fwd(Params p) {
    extern __shared__ __attribute__((aligned(16))) unsigned char lds_raw[];
    LAS unsigned char* lds = (LAS unsigned char*)lds_raw;
    cg::grid_group grid = cg::this_grid();
    if (threadIdx.x < 4) ((LAS unsigned*)(lds + 131072 + 1024))[threadIdx.x] = 0u;
    __syncthreads();
    XcdBarrier xbar = xcd_barrier_post((unsigned*)(p.ws + WS_CTL + 4096), (volatile LAS unsigned*)(lds + 131072 + 1024));
    const int G = gridDim.x, bid = blockIdx.x, ngw = G * 8, gthreads = G * 512;
    int st = 0;
#define PHASE(...) do { if (st >= p.step_lo && st < p.step_hi) { __VA_ARGS__; if (st + 1 < p.step_hi) { if (p.step_hi < 0) grid.sync(); else xcd_barrier(xbar); } } ++st; } while (0)
#define GEMM_STORE(ACT, Aptr, lda_, Bptr, ldb_, M_, N_, K_, Optr, ldc_, ssr_, mode_, tab_, smask_, rmod_, rlim_, cid_) do { pg8::Gemm g_{(Aptr), (Bptr), (M_), (N_), (K_), (lda_), (ldb_)}; pg8::StaticOrder S_; S_.init((M_), (N_), G, (cid_)); \
        pg8::EpiStore<ACT> E_{(Optr), (ldc_), (ssr_), (mode_), (tab_), (smask_), (rmod_), (rlim_)}; pg8::gemm_phase<pg8::EpiStore<ACT>, pg8::StaticOrder, true, true>(lds, g_, S_, E_); } while (0)
#define GEMM_RESID(Aptr, lda_, Bptr, ldb_, M_, N_, K_, Xptr, ldc_, xb_, ssw_) do { pg8::Gemm g_{(Aptr), (Bptr), (M_), (N_), (K_), (lda_), (ldb_)}; pg8::StaticOrder S_; S_.init((M_), (N_), G, bid); \
        pg8::EpiResid E_{(xb_), (ldc_), (ssw_)}; pg8::gemm_phase<pg8::EpiResid, pg8::StaticOrder, true, true>(lds, g_, S_, E_); } while (0)

#define TR(src, K_, N_, nl, dstoff, dstlstride, per_, hi_, sc_, gn_, gstr_) do { const int ipl_ = ((K_) / 64) * ((N_) / 32), tot_ = ipl_ * (nl); \
            for (int it = gw - base; it < tot_; it += ngw) { if (it < 0) continue; const int l_ = it / ipl_, r_ = it - l_ * ipl_; \
                transpose_item((src) + (size_t)l_ * (K_) * (N_), (K_), (N_), Wb + (dstoff) + (size_t)l_ * (dstlstride), scr, r_, lane, (per_), (hi_), (sc_), (gn_) ? (gn_) + (size_t)l_ * (gstr_) : (const float*)nullptr); \
                asm volatile("s_waitcnt lgkmcnt(0)" ::: "memory"); } \
            base = (base + tot_) % ngw; } while (0)
    PHASE({
        const int tid = threadIdx.x, lane = tid & 63, wave = __builtin_amdgcn_readfirstlane(tid >> 6);
        const int gw = bid * 8 + wave, gtid = bid * 512 + tid;
        unsigned char* ws = p.ws;
        bf16_t* Wb = (bf16_t*)(ws + WS_W);
        f32x2* tabA = (f32x2*)(ws + TAB_A); f32x2* tabB = (f32x2*)(ws + TAB_B); f32x2* tabD = (f32x2*)(ws + TAB_D);
        bf16_t* MN = (bf16_t*)(ws + WS_MN); float* lamp = (float*)(ws + WS_CTL);
        LAS float* scr = (LAS float*)(lds + wave * 16384);
        int base = 0;
        TR(p.in[11], 1024, 4096, 4, WL_MI, WL_SZ, 1 << 30, 0, 1.0f, p.in[10], DM);
        TR(p.in[12], 4096, 1024, 4, WL_MO, WL_SZ, 1 << 30, 0, 1.0f, (const float*)nullptr, 0);
        TR(p.in[7], 1024, 512, 4, WL_XQ, WL_SZ, 1 << 30, 1 << 30, 0.08838834764831845f * LOG2E, p.in[5], DM);
        TR(p.in[8], 1024, 1024, 4, WL_XKV, WL_SZ, 1 << 30, 0, 1.0f, (const float*)nullptr, 0);
        TR(p.in[9], 512, 1024, 4, WL_XO, WL_SZ, 1 << 30, 0, 1.0f, (const float*)nullptr, 0);
        TR(p.in[13], 1024, 4608, 1, W_A_IN, 0, 1536, 512, 0.125f * LOG2E, p.in[4] + 0 * DM, 0);
        TR(p.in[14], 512, 1024, 1, W_A_OUT, 0, 1 << 30, 0, 1.0f, (const float*)nullptr, 0);
        TR(p.in[15], 1024, 1536, 1, W_B_IN, 0, 1 << 30, 0, 1.0f, p.in[4] + 1 * DM, 0);
        TR(p.in[18], 1024, 1024, 1, W_B_OUT, 0, 1 << 30, 0, 1.0f, (const float*)nullptr, 0);
        TR(p.in[19], 1024, 3072, 1, W_C_IN, 0, 1 << 30, 1024, 0.125f * LOG2E, p.in[4] + 2 * DM, 0);
        TR(p.in[25], 1024, 1024, 1, W_C_OUT, 0, 1 << 30, 0, 1.0f, (const float*)nullptr, 0);
        TR(p.in[26], 1024, 672, 1, W_D_IN, 0, 1 << 30, 0, 1.0f, p.in[4] + 3 * DM, 0);
        TR(p.in[29], 384, 1536, 1, W_D_UQ, 0, 1 << 30, 1 << 30, 0.10206207261596575f * LOG2E, (const float*)nullptr, 0);
        TR(p.in[30], 256, 2048, 1, W_D_UKV, 0, 1 << 30, 0, 1.0f, (const float*)nullptr, 0);
        TR(p.in[31], 1024, 1024, 1, W_D_OUT, 0, 1 << 30, 0, 1.0f, (const float*)nullptr, 0);
        for (int i = gtid; i < (int)(SS_BYTES / 16); i += gthreads) *(u32x4*)(ws + WS_SS + (size_t)i * 16) = (u32x4){0u, 0u, 0u, 0u};
        for (int i = gtid; i < 96 * 1024 / 8; i += gthreads) *(u32x4*)(Wb + W_D_IN + (size_t)672 * 1024 + (size_t)i * 8) = (u32x4){0u, 0u, 0u, 0u};
        for (int i = gtid; i < 8192 * 8; i += gthreads) tabA[i] = cs_of((double)(i >> 3), p.invfA[i & 7]);
        for (int i = gtid; i < 8192 * 16; i += gthreads) tabD[i] = cs_of((double)(i >> 4), p.invfD[i & 15]);
        for (int i = gtid; i < 128 * 16; i += gthreads) tabB[i] = cs_of((double)(i >> 4), p.invfB[i & 15]);
        if (bid == 0 && wave == 0) { const float a = wave_sum(p.in[20][lane] * p.in[21][lane]), b = wave_sum(p.in[22][lane] * p.in[23][lane]);
            if (lane == 0) lamp[0] = __expf(a) - __expf(b) + p.lam_init;
            float gq = fabsf(p.in[16][lane]), gk = fabsf(p.in[17][lane]);
            _Pragma("unroll") for (int o = 1; o < 64; o <<= 1) { gq = fmaxf(gq, __shfl_xor(gq, o)); gk = fmaxf(gk, __shfl_xor(gk, o)); }
            if (lane == 0) lamp[1] = 8.0f * gq * 8.0f * gk * 0.125f * LOG2E; }
        for (int it = gw; it < DEPTH * NMEMROWS; it += ngw) { const int i = it / NMEMROWS, r = it - i * NMEMROWS;
            const float* src = r < 512 ? p.in[2] + (size_t)r * DM : p.in[3] + (size_t)(r - 512) * DM;
            norm_row_bf16(src, p.in[6] + i * DM, MN + (size_t)it * DM, lane); }
    });
#pragma nounroll
    for (int ch = 0; ch < NCH; ++ch) {
        const int S = ch == 0 ? 8192 : 4096, nseq = TC / S, gseq0 = ch == 0 ? 0 : 2 + 4 * (ch - 1);
        const int nqb = S / 256;
        PHASE({ int tid = threadIdx.x; asm volatile("" : "+v"(tid)); const int lane = tid & 63, wave = __builtin_amdgcn_readfirstlane(tid >> 6); const int gw = bid * 8 + wave;
                unsigned char* wsb = p.ws; asm volatile("" : "+s"(wsb)); wsb = (unsigned char*)(GASP unsigned char*)wsb; float* outb = p.out; asm volatile("" : "+s"(outb)); outb = (float*)(GASP float*)outb;
                const float* xin = ch == 0 ? p.in[0] : p.in[1] + (size_t)(ch - 1) * TC * DM; asm volatile("" : "+s"(xin)); xin = (const float*)(const GASP float*)xin; float* xo = outb + (size_t)ch * TC * DM;
                bf16_t* Hb = (bf16_t*)(wsb + WS_H); unsigned long long* ss0 = (unsigned long long*)(wsb + WS_SS) + (size_t)(ch * 15) * TC;
                for (int r = gw; r < TC; r += ngw) start_row(xin + (size_t)r * DM, Hb + (size_t)r * DM, ss0 + r, lane); });
#pragma nounroll
        for (int li = 0; li < DEPTH; ++li) {
            const int nmix = li == 3 ? 3 : 2;
            const int nsub = 7 + nmix;
#pragma nounroll
            for (int sub2 = 0; sub2 < nsub * PROBE_REP; ++sub2) {
                const int sub = sub2 / PROBE_REP, dup = sub2 % PROBE_REP;
                unsigned char* ws = p.ws; asm volatile("" : "+s"(ws)); ws = (unsigned char*)(GASP unsigned char*)ws;
                float* outp = p.out; asm volatile("" : "+s"(outp)); outp = (float*)(GASP float*)outp;
                int tid = threadIdx.x; asm volatile("" : "+v"(tid));
                const int lane = tid & 63, wave = __builtin_amdgcn_readfirstlane(tid >> 6);
                const int gw = bid * 8 + wave, gtid = bid * 512 + tid;
                const int vcu = (G % 8 == 0) ? (bid % 8) * (G / 8) + bid / 8 : bid;
                bf16_t* Wb = (bf16_t*)(ws + WS_W);
                f32x2* tabA = (f32x2*)(ws + TAB_A); f32x2* tabB = (f32x2*)(ws + TAB_B); f32x2* tabD = (f32x2*)(ws + TAB_D);
                bf16_t* MN = (bf16_t*)(ws + WS_MN); bf16_t* KVM = (bf16_t*)(ws + WS_KVM); bf16_t* H = (bf16_t*)(ws + WS_H); bf16_t* AO = (bf16_t*)(ws + WS_AO);
                float* LSE = (float*)(ws + WS_LSE); bf16_t* BIG = (bf16_t*)(ws + WS_BIG); bf16_t* QX = (bf16_t*)(ws + WS_X2);
                float* lamp = (float*)(ws + WS_CTL);
                float* X = outp + (size_t)ch * TC * DM;
                int op, garg = 0;
                const int ms = sub - 1, tail = sub - 1 - nmix;
                if (sub == 0) { op = 1; garg = 0; }
                else if (ms < nmix) {
                    if (li == 0) op = ms == 0 ? 6 : 11;
                    else if (li == 1) op = ms == 0 ? 3 : 7;
                    else if (li == 2) op = ms == 0 ? 8 : 12;
                    else { op = ms == 0 ? 4 : (ms == 1 ? 1 : 9); garg = 6; }
                } else {
                    switch (tail) { case 0: op = 1; garg = 1; break; case 1: op = 1; garg = 2; break; case 2: op = 10; break;
                                    case 3: op = 1; garg = 3; break; case 4: op = 1; garg = 4; break; default: op = 1; garg = 5; break; }
                }
                unsigned long long* SSl = (unsigned long long*)(ws + WS_SS) + (size_t)((ch * 5 + li) * 3) * TC;
                const bool skip = dup && !((PROBE_ATT2 && op >= 7 && op <= 10) || (PROBE_GST2 && op == 1 && (garg == 0 || garg == 2 || garg == 4 || garg == 6)) || (PROBE_PREP2 && (op == 11 || op == 12)));
                PHASE({
                  if (!skip) {
                    if (op == 1) {
                        const int nrep = (garg == 6 || (garg == 2 && ch == 0)) ? 2 : 1;
_Pragma("nounroll")
                        for (int rep = 0; rep < nrep; ++rep) {
                            const bf16_t* A_ = H; const bf16_t* B_ = Wb; void* O_ = BIG; int lda_ = DM, N_ = 1024, K_ = 1024, M_ = TC, kind = 0; unsigned long long* ss_ = nullptr; int mode_ = 0, rmod_ = 1, rlim_ = 0, cid_ = bid; const float* tab_ = nullptr;
                            if (garg == 0) { B_ = Wb + (li == 0 ? W_A_IN : (li == 1 ? W_B_IN : (li == 2 ? W_C_IN : W_D_IN))); N_ = li == 0 ? 4608 : (li == 1 ? 1536 : (li == 2 ? 3072 : 768)); ss_ = SSl;
                                              if (li == 0) { mode_ = 1; tab_ = (const float*)tabA; rmod_ = 6; rlim_ = 4; } else if (li == 2) { mode_ = 1; tab_ = (const float*)tabA; rmod_ = 1 << 20; rlim_ = 8; } }
                            else if (garg == 1) { A_ = AO; K_ = li == 0 ? 512 : 1024; lda_ = K_; B_ = Wb + (li == 0 ? W_A_OUT : (li == 1 ? W_B_OUT : (li == 2 ? W_C_OUT : W_D_OUT))); O_ = X; kind = 2; ss_ = SSl + TC; }
                            else if (garg == 2) { if (rep == 0) { B_ = Wb + (size_t)li * WL_SZ + WL_XQ; N_ = 512; O_ = QX; ss_ = SSl + TC; }
                                                  else { A_ = MN + (size_t)li * NMEMROWS * DM; B_ = Wb + (size_t)li * WL_SZ + WL_XKV; M_ = NMEMROWS; O_ = KVM + (size_t)li * NMEMROWS * DM; cid_ = (bid + G / 2) % G; } }
                            else if (garg == 3) { A_ = AO; K_ = 512; lda_ = 512; B_ = Wb + (size_t)li * WL_SZ + WL_XO; O_ = X; kind = 2; ss_ = SSl + 2 * TC; }
                            else if (garg == 4) { B_ = Wb + (size_t)li * WL_SZ + WL_MI; N_ = 4096; kind = 1; ss_ = SSl + 2 * TC; }
                            else if (garg == 5) { A_ = BIG; K_ = 4096; lda_ = 4096; B_ = Wb + (size_t)li * WL_SZ + WL_MO; O_ = X; kind = 2; ss_ = SSl + 3 * TC; }
                            else { if (rep == 0) { A_ = BIG + (size_t)12 * MiB; K_ = 384; lda_ = 384; B_ = Wb + W_D_UQ; N_ = 1536; O_ = BIG + (size_t)24 * MiB; mode_ = 2; tab_ = (const float*)tabD; }
                                   else { A_ = BIG + (size_t)18 * MiB; K_ = 256; lda_ = 256; B_ = Wb + W_D_UKV; N_ = 2048; O_ = BIG + (size_t)48 * MiB; } }
                            if (kind == 0) GEMM_STORE(0, A_, lda_, B_, K_, M_, N_, K_, (bf16_t*)O_, N_, (const unsigned long long*)ss_, mode_, tab_, S - 1, rmod_, rlim_, cid_);
                            else if (kind == 1) GEMM_STORE(1, A_, lda_, B_, K_, M_, N_, K_, (bf16_t*)O_, N_, (const unsigned long long*)ss_, 0, (const float*)nullptr, 0, 1, 0, bid);
                            else GEMM_RESID(A_, lda_, B_, K_, M_, N_, K_, (float*)O_, DM, H, ss_);
                        }
                    } else if (op == 3) { prep_b(BIG, p.in[16], p.in[17], S, tabB, gtid, gthreads);
                    } else if (op == 4) { prep_d1(BIG, BIG + (size_t)12 * MiB, BIG + (size_t)18 * MiB, BIG + (size_t)22 * MiB, p.in[27], p.in[28], S, tabD, gw, ngw, lane);
                    } else if (op == 6) {
                        const int nunits = nseq * 3 * 8 * nqb;
_Pragma("nounroll")
                        for (int u = vcu; u < nunits; u += G) {
                            int r = u; const int qb = r % nqb; r /= nqb; const int h = r % 8; r /= 8; const int g = r % 3; const int sq = r / 3;
                            const int dil = g == 0 ? 1 : (g == 1 ? 4 : 16); const int L = S / dil, bpr = L / 256;
                            const int res = qb / bpr, q0 = (qb % bpr) * 256;
                            bf16_t* base = BIG + ((size_t)sq * S + res) * 4608 + g * 1536 + h * 64;
                            AttnArgs a; a.nomax = 0; a.q = base + (size_t)q0 * dil * 4608; a.qs = (long)dil * 4608; a.k = base + 512; a.ks = a.qs; a.k2 = nullptr; a.k2s = 0; a.v = base + 1024; a.vs = a.qs;
                            a.o = base + (size_t)q0 * dil * 4608; a.os = a.qs; a.lse = LSE + ((size_t)g * TC + (size_t)sq * S + res + (size_t)q0 * dil) * 8 + h; a.lses = (long)dil * 8;
                            a.kv_len = L; a.q0 = q0;
                            attn_unit<64, 64, true>(a, lds, tid);
                        }
                    } else if (op == 7) {
                        const int nunits = nseq * 16 * nqb;
_Pragma("nounroll")
                        for (int u = vcu; u < nunits; u += G) {
                            int r = u; const int qb = r % nqb; r /= nqb; const int h = r % 16; const int sq = r / 16;
                            const size_t row0 = (size_t)sq * S;
                            AttnArgs a; a.nomax = 0; a.q = BIG + (row0 + qb * 256) * 1536 + h * 64; a.qs = 1536; a.k = BIG + row0 * 1536 + 1024 + (h >> 2) * 64; a.ks = 1536; a.k2 = nullptr; a.k2s = 0;
                            a.v = BIG + row0 * 1536 + 1280 + (h >> 2) * 64; a.vs = 1536; a.o = AO + (row0 + qb * 256) * 1024 + h * 64; a.os = 1024; a.lse = nullptr; a.lses = 0;
                            a.kv_len = S; a.q0 = qb * 256; a.nomax = lamp[1] <= 40.0f ? 1 : 0;
                            attn_unit<64, 64, false>(a, lds, tid);
                        }
                    } else if (op == 8) {
                        bf16_t* OC = BIG + (size_t)TC * 3072;
                        const int nunits = nseq * 16 * nqb;
_Pragma("nounroll")
                        for (int u = vcu; u < nunits; u += G) {
                            int r = u; const int qb = r % nqb; r /= nqb; const int hc = r % 16; const int sq = r / 16;
                            const size_t row0 = (size_t)sq * S;
                            AttnArgs a; a.nomax = 0; a.q = BIG + (row0 + qb * 256) * 3072 + hc * 64; a.qs = 3072; a.k = BIG + row0 * 3072 + 1024 + hc * 64; a.ks = 3072; a.k2 = nullptr; a.k2s = 0;
                            a.v = BIG + row0 * 3072 + 2048 + (hc >> 1) * 128; a.vs = 3072; a.o = OC + (row0 + qb * 256) * 2048 + hc * 128; a.os = 2048; a.lse = nullptr; a.lses = 0;
                            a.kv_len = S; a.q0 = qb * 256;
                            attn_unit<64, 128, false>(a, lds, tid);
                        }
                    } else if (op == 9) {
                        bf16_t* KR = BIG + (size_t)22 * MiB; bf16_t* QD = BIG + (size_t)24 * MiB; bf16_t* KVD = BIG + (size_t)48 * MiB;
                        const int nunits = nseq * 16 * nqb;
_Pragma("nounroll")
                        for (int u = vcu; u < nunits; u += G) {
                            int r = u; const int qb = r % nqb; r /= nqb; const int h = r % 16; const int sq = r / 16;
                            const size_t row0 = (size_t)sq * S;
                            AttnArgs a; a.nomax = 0; a.q = QD + (row0 + qb * 256) * 1536 + h * 96; a.qs = 1536; a.k = KVD + row0 * 2048 + h * 128; a.ks = 2048; a.k2 = KR + row0 * 32; a.k2s = 32;
                            a.v = KVD + row0 * 2048 + h * 128 + 64; a.vs = 2048; a.o = AO + (row0 + qb * 256) * 1024 + h * 64; a.os = 1024; a.lse = nullptr; a.lses = 0;
                            a.kv_len = S; a.q0 = qb * 256;
                            attn_unit<96, 64, false>(a, lds, tid);
                        }
                    } else if (op == 10) {
                        const int nunits = (TC / 256) * 4;
_Pragma("nounroll")
                        for (int u = vcu; u < nunits; u += G) {
                            const int h = u & 3, rb = u >> 2; const int sq = (rb * 256) / S;
                            const bf16_t* kvb = KVM + ((size_t)li * NMEMROWS + (size_t)(gseq0 + sq) * 256) * DM + h * 128;
                            AttnArgs a; a.nomax = 0; a.q = QX + (size_t)rb * 256 * 512 + h * 128; a.qs = 512; a.k = kvb; a.ks = DM; a.k2 = nullptr; a.k2s = 0; a.v = kvb + 512; a.vs = DM;
                            a.o = AO + (size_t)rb * 256 * 512 + h * 128; a.os = 512; a.lse = nullptr; a.lses = 0; a.kv_len = 256; a.q0 = 0;
                            attn_unit<128, 128, false>(a, lds, tid);
                        }
                    } else if (op == 11) { merge_a(BIG, LSE, AO, gtid, gthreads);
                    } else { combine_c(BIG + (size_t)TC * 3072, AO, p.in[24], lamp[0], p.one_minus_li, gtid, gthreads); }
                  }
                });
            }
        }
        PHASE({ int tid = threadIdx.x; asm volatile("" : "+v"(tid)); const int lane = tid & 63, wave = __builtin_amdgcn_readfirstlane(tid >> 6); const int gw = bid * 8 + wave;
                unsigned char* wsb = p.ws; asm volatile("" : "+s"(wsb)); wsb = (unsigned char*)(GASP unsigned char*)wsb; float* outb = p.out; asm volatile("" : "+s"(outb)); outb = (float*)(GASP float*)outb; const float* fg = p.in[32]; asm volatile("" : "+s"(fg)); fg = (const float*)(const GASP float*)fg;
                const unsigned long long* ssf = (const unsigned long long*)(wsb + WS_SS) + (size_t)((ch * 5 + 4) * 3) * TC; float* xo = outb + (size_t)ch * TC * DM;
                const bf16_t* Hb = (const bf16_t*)(wsb + WS_H);
                for (int r = gw; r < TC; r += ngw) final_row(Hb + (size_t)r * DM, xo + (size_t)r * DM, fg, ((const GASP unsigned long long*)ssf)[r], lane); });
    }
#undef PHASE
}
constexpr int NSTEPS = 1 + NCH * (1 + 4 * 7 + 3 + 2 + 3 + 4) + 1;

extern "C" void kernel_launch(void* const* d_in, const int* in_sizes, int n_in, void* d_out, int out_size, void* d_ws, size_t ws_size, hipStream_t stream) {
    static int grid = 0;
    if (grid == 0) {
        if (n_in != 33 || out_size != NTOK * DM || ws_size < WS_END) { fprintf(stderr, "kernel_launch: unexpected shapes (n_in %d out %d ws %zu)\n", n_in, out_size, ws_size); grid = -1; return; }
        int dev = 0, cus = 0, per_cu = 0;
        (void)hipGetDevice(&dev); (void)hipDeviceGetAttribute(&cus, hipDeviceAttributeMultiprocessorCount, dev);
        if (hipFuncSetAttribute((const void*)mega_fwd, hipFuncAttributeMaxDynamicSharedMemorySize, LDS_BYTES) != hipSuccess) { fprintf(stderr, "kernel_launch: hipFuncSetAttribute failed\n"); grid = -1; return; }
        if (hipOccupancyMaxActiveBlocksPerMultiprocessor(&per_cu, (const void*)mega_fwd, 512, LDS_BYTES) != hipSuccess || per_cu < 1) { fprintf(stderr, "kernel_launch: occupancy query gave %d\n", per_cu); per_cu = 1; }
        (void)hipGetLastError();
        grid = cus * 1;
        fprintf(stderr, "kernel_launch: cus %d per_cu %d grid %d\n", cus, per_cu, grid);
    }
    if (grid < 0) return;
    if (hipMemsetAsync((char*)d_ws + WS_CTL, 0, 65536, stream) != hipSuccess) { fprintf(stderr, "kernel_launch: memset failed\n"); return; }
    Params p{};
    for (int i = 0; i < 33; ++i) p.in[i] = (const float*)d_in[i];
    p.out = (float*)d_out; p.ws = (unsigned char*)d_ws;
    for (int i = 0; i < 8; ++i) p.invfA[i] = std::exp((double)i * (-2.0 * std::log(500000.0) / 16.0));
    for (int i = 0; i < 16; ++i) p.invfD[i] = std::exp((double)i * (-2.0 * std::log(500000.0) / 32.0));
    for (int i = 0; i < 16; ++i) p.invfB[i] = std::exp((double)i * (-2.0 * std::log(10000.0) / 32.0));
    const double li = 0.8 - 0.6 * std::exp(-0.3 * 2.0);
    p.lam_init = (float)li; p.one_minus_li = (float)(1.0 - li);
#if MK_MULTI
    for (int s = 0; s < NSTEPS; ++s) { p.step_lo = s; p.step_hi = s + 1; void* args[] = {&p};
        hipError_t e = hipLaunchCooperativeKernel((const void*)mega_fwd, dim3(grid), dim3(512), args, LDS_BYTES, stream);
        if (e != hipSuccess) { fprintf(stderr, "launch %d failed: %s\n", s, hipGetErrorString(e)); break; } }
#else
    p.step_lo = 0; p.step_hi = 1 << 30; void* args[] = {&p};
    hipError_t e = hipLaunchCooperativeKernel((const void*)mega_fwd, dim3(grid), dim3(512), args, LDS_BYTES, stream);
    if (e != hipSuccess) fprintf(stderr, "cooperative launch failed: %s (grid %d)\n", hipGetErrorString(e), grid);
#endif
}
```

```cpp
#include <hip/hip_runtime.h>
#include <hip/hip_cooperative_groups.h>
#include <cstdio>
#include <cstdint>
#include <cmath>
namespace cg = cooperative_groups;
#ifndef MK_MULTI
#define MK_MULTI 0
#endif
#ifndef PROBE_ATT2
#define PROBE_ATT2 0
#endif
#ifndef PROBE_NORM2
#define PROBE_NORM2 0
#endif
#ifndef PROBE_GST2
#define PROBE_GST2 0
#endif
#ifndef PROBE_REP
#define PROBE_REP 1
#endif
#ifndef PROBE_PREP2
#define PROBE_PREP2 0
#endif
namespace pg8 {
#define PG8_LAS __attribute__((address_space(3)))
#define PG8_GAS __attribute__((address_space(1)))
typedef unsigned short bf16_t;
typedef short bf16x8 __attribute__((ext_vector_type(8)));
typedef float f32x4 __attribute__((ext_vector_type(4)));
typedef unsigned u32x4 __attribute__((ext_vector_type(4)));
constexpr int BM = 256, BK = 64, HALF = 128, HTB = HALF * BK * 2  , STAGE_BYTES = 8 * HTB, NXCD = 8, WGM = 4;

__host__ __device__ __forceinline__ int lds_byte(int r, int c) { const int st = (r >> 4) * 2 + (c >> 5), rr = r & 15, cc = c & 31, ob = rr * 64 + cc * 2; return st * 1024 + (ob ^ (((ob >> 9) & 1) << 5)); }
__host__ __device__ __forceinline__ void stage_rc(int b, int& R, int& C) { const int st = b / 1024, sb = b % 1024, swz = sb ^ (((sb >> 9) & 1) << 5); R = (st >> 1) * 16 + swz / 64; C = (st & 1) * 32 + (swz % 64) / 2; }
__host__ __device__ __forceinline__ int perm32(int rho) { const int n = rho >> 4, i = rho & 15; return 8 * (i >> 2) + 4 * n + (i & 3); }

struct Unit { int pm, pn; };
struct Gemm { const bf16_t* A; const bf16_t* Bt; int M, N, K, lda, ldb; };

struct StaticOrder {
    int nM, nN, nwg, G, c;
    __host__ __device__ void init(int M, int N, int G_, int c_) { nM = M / BM; nN = N / BM; nwg = nM * nN; G = G_; c = c_; }
    __host__ __device__ bool next(int i, Unit& u) const {
        const long L = (long)i * G + c; if (L >= nwg) return false;
        int wgid = (int)L; { const int q = nwg / NXCD, r = nwg % NXCD, xcd = wgid % NXCD, off = wgid / NXCD; wgid = (xcd < r ? xcd * (q + 1) : r * (q + 1) + (xcd - r) * q) + off; }
        const int nig = WGM * nN, gid = wgid / nig, fm = gid * WGM, gsz = (nM - fm) < WGM ? (nM - fm) : WGM;
        u.pm = fm + ((wgid % nig) % gsz); u.pn = (wgid % nig) / gsz; return true;
    }
    __device__ __forceinline__ void a_ready(const Unit&) const {}
    __device__ __forceinline__ void done(const Unit&) const {}
};

__device__ __forceinline__ unsigned cvt_pk_bf16(float lo, float hi) { unsigned r; asm volatile("v_cvt_pk_bf16_f32 %0, %1, %2" : "=v"(r) : "v"(lo), "v"(hi)); return r; }
typedef float f32x2 __attribute__((ext_vector_type(2)));
template <int ACT  > struct EpiStore {
    static constexpr bool PERM = true, AFTER_DRAIN = false;
    bf16_t* O; int ldc; const unsigned long long* ss;
    int mode; const float* tab; int smask, rmod, rlim;
    __device__ __forceinline__ void operator()(const f32x4 (&acc)[2][2][4][2], const Unit& u, int wr, int wc, int fr, int fq) const {
        const int row0 = u.pm * BM + wr * 64 + fr; const int col0 = u.pn * BM + wc * 32 + 8 * fq;
        float rsv[2][4];
        if (ss) { unsigned long long sv[2][4];
#pragma unroll
            for (int ai = 0; ai < 2; ++ai)
#pragma unroll
                for (int m = 0; m < 4; ++m) sv[ai][m] = ((const PG8_GAS unsigned long long*)ss)[row0 + ai * HALF + m * 16];
#pragma unroll
            for (int ai = 0; ai < 2; ++ai)
#pragma unroll
                for (int m = 0; m < 4; ++m) rsv[ai][m] = 1.0f / sqrtf((float)sv[ai][m] * (1.0f / (1024.0f * 1048576.0f)) + 1e-6f);
        } else {
#pragma unroll
            for (int ai = 0; ai < 2; ++ai)
#pragma unroll
                for (int m = 0; m < 4; ++m) rsv[ai][m] = 1.0f; }
#pragma unroll
        for (int ai = 0; ai < 2; ++ai)
#pragma unroll
            for (int m = 0; m < 4; ++m) { PG8_GAS bf16_t* rowp = (PG8_GAS bf16_t*)O + (size_t)(row0 + ai * HALF + m * 16) * ldc + col0;
                const float rs = rsv[ai][m];
#pragma unroll
                for (int bj = 0; bj < 2; ++bj) { f32x4 v0 = acc[ai][bj][m][0] * rs, v1 = acc[ai][bj][m][1] * rs;
                    if (mode != 0) {
                        const bool span = mode == 1 ? ((wc & 1) == 0 && (u.pn % rmod) < rlim) : (((u.pn * 8 + bj * 4 + wc) % 3) == 2);
                        if (span) {
                            const int pos = (row0 + ai * HALF + m * 16) & smask;
                            const PG8_GAS f32x4* t4 = (const PG8_GAS f32x4*)((const PG8_GAS float*)tab + (mode == 1 ? (size_t)pos * 16 : (size_t)pos * 32 + 16 * (fq & 1)));
                            const int dist = mode == 1 ? 16 : 32; const bool part = mode == 1 ? fq < 2 : true; const bool firsth = mode == 1 ? fq == 0 : fq < 2;
                            const f32x4 c0 = t4[0], c1 = t4[1], c2 = t4[2], c3 = t4[3];
                            f32x4 o0, o1;
#pragma unroll
                            for (int e = 0; e < 4; ++e) { o0[e] = __shfl_xor(v0[e], dist); o1[e] = __shfl_xor(v1[e], dist); }
                            if (part) { const float sg = firsth ? -1.0f : 1.0f;
                                v0[0] = v0[0] * c0.x + sg * o0[0] * c0.y; v0[1] = v0[1] * c0.z + sg * o0[1] * c0.w; v0[2] = v0[2] * c1.x + sg * o0[2] * c1.y; v0[3] = v0[3] * c1.z + sg * o0[3] * c1.w;
                                v1[0] = v1[0] * c2.x + sg * o1[0] * c2.y; v1[1] = v1[1] * c2.z + sg * o1[1] * c2.w; v1[2] = v1[2] * c3.x + sg * o1[2] * c3.y; v1[3] = v1[3] * c3.z + sg * o1[3] * c3.w; }
                        }
                    }
                    if (ACT == 1) {
#pragma unroll
                        for (int e = 0; e < 4; ++e) { float a = v0[e] > 0.f ? v0[e] : 0.f; v0[e] = a * a; float b = v1[e] > 0.f ? v1[e] : 0.f; v1[e] = b * b; } }
                    u32x4 w; w.x = cvt_pk_bf16(v0[0], v0[1]); w.y = cvt_pk_bf16(v0[2], v0[3]); w.z = cvt_pk_bf16(v1[0], v1[1]); w.w = cvt_pk_bf16(v1[2], v1[3]);
                    *(PG8_GAS u32x4*)(rowp + bj * HALF) = w; } }
    }
};
struct EpiResid {
    static constexpr bool PERM = true, AFTER_DRAIN = false;
    bf16_t* XB; int ldc; unsigned long long* ss;
    __device__ __forceinline__ void operator()(const f32x4 (&acc)[2][2][4][2], const Unit& u, int wr, int wc, int fr, int fq) const {
        const int row0 = u.pm * BM + wr * 64 + fr; const int col0 = u.pn * BM + wc * 32 + 8 * fq;
        PG8_GAS bf16_t* XBg = (PG8_GAS bf16_t*)XB; PG8_GAS unsigned long long* ssg = (PG8_GAS unsigned long long*)ss;
        u32x4 pre[2][4][2];
#pragma unroll
        for (int ai = 0; ai < 2; ++ai)
#pragma unroll
            for (int m = 0; m < 4; ++m)
#pragma unroll
                for (int bj = 0; bj < 2; ++bj) pre[ai][m][bj] = *(const PG8_GAS u32x4*)(XBg + (size_t)(row0 + ai * HALF + m * 16) * ldc + col0 + bj * HALF);
#pragma unroll
        for (int ai = 0; ai < 2; ++ai)
#pragma unroll
            for (int m = 0; m < 4; ++m) { const int row = row0 + ai * HALF + m * 16; PG8_GAS bf16_t* rowb = XBg + (size_t)row * ldc + col0;
                float sq = 0.f;
#pragma unroll
                for (int bj = 0; bj < 2; ++bj) { const u32x4 o = pre[ai][m][bj]; const f32x4 c0 = acc[ai][bj][m][0], c1 = acc[ai][bj][m][1];
                    u32x4 w; w.x = cvt_pk_bf16(__uint_as_float(o.x << 16) + c0[0], __uint_as_float(o.x & 0xffff0000u) + c0[1]); w.y = cvt_pk_bf16(__uint_as_float(o.y << 16) + c0[2], __uint_as_float(o.y & 0xffff0000u) + c0[3]);
                    w.z = cvt_pk_bf16(__uint_as_float(o.z << 16) + c1[0], __uint_as_float(o.z & 0xffff0000u) + c1[1]); w.w = cvt_pk_bf16(__uint_as_float(o.w << 16) + c1[2], __uint_as_float(o.w & 0xffff0000u) + c1[3]);
                    *(PG8_GAS u32x4*)(rowb + bj * HALF) = w;
                    const float a0 = __uint_as_float(w.x << 16), a1 = __uint_as_float(w.x & 0xffff0000u), a2 = __uint_as_float(w.y << 16), a3 = __uint_as_float(w.y & 0xffff0000u);
                    const float b0 = __uint_as_float(w.z << 16), b1 = __uint_as_float(w.z & 0xffff0000u), b2 = __uint_as_float(w.w << 16), b3 = __uint_as_float(w.w & 0xffff0000u);
                    sq += (a0 * a0 + a1 * a1) + (a2 * a2 + a3 * a3) + (b0 * b0 + b1 * b1) + (b2 * b2 + b3 * b3); }
                sq += __shfl_xor(sq, 16); sq += __shfl_xor(sq, 32);
                if (fq == 0) __hip_atomic_fetch_add(ssg + row, (unsigned long long)(sq * 1048576.0f + 0.5f), __ATOMIC_RELAXED, __HIP_MEMORY_SCOPE_AGENT); }
    }
};

template <class Epi, class Sched, bool ALIGN_EPI = false, bool SP2 = false>
__device__ __forceinline__ void gemm_phase(PG8_LAS unsigned char* lds, const Gemm g, const Sched& S, const Epi& E) {
    const int tid = threadIdx.x, wid = __builtin_amdgcn_readfirstlane(tid >> 6), lane = tid & 63, wr = wid >> 2, wc = wid & 3, fr = lane & 15, fq = lane >> 4;
    const int K = g.K, nt = K / BK;
    unsigned voffA[2], voffB[2];
#pragma unroll
    for (int i = 0; i < 2; ++i) { int R, C; stage_rc(tid * 16 + i * 8192, R, C); const int Rb = Epi::PERM ? ((R & ~31) + perm32(R & 31)) : R;
        voffA[i] = (unsigned)(R * g.lda + C) * 2u; voffB[i] = (unsigned)(Rb * g.ldb + C) * 2u; }
    const size_t kstep = (size_t)(BK * 2);
    const size_t hstepA = (size_t)HALF * g.lda * 2, hstepB = (size_t)HALF * g.ldb * 2;
    const size_t tstepA = 2 * hstepA, tstepB = 2 * hstepB;
    const unsigned ldsw = (unsigned)wid * 1024u;
    const int aoff = lds_byte(wr * 64 + fr, fq * 8), boff = lds_byte(wc * 32 + fr, fq * 8);
#define PG8_SA(b, h) (((b) * 2 + (h)) * HTB)
#define PG8_SB(b, h) ((4 + (b) * 2 + (h)) * HTB)
#define PG8_STAGE(bufoff, gbase, voff) do { _Pragma("unroll") for (int _i = 0; _i < 2; ++_i) \
        __builtin_amdgcn_global_load_lds((const unsigned*)((const char*)(gbase) + (voff)[_i]), (PG8_LAS unsigned*)(lds + (bufoff) + ldsw + _i * 8192), 16, 0, 0); } while (0)
#define PG8_LDA(dst, b, h) do { _Pragma("unroll") for (int m = 0; m < 4; ++m) _Pragma("unroll") for (int k = 0; k < 2; ++k) dst[m][k] = *(const PG8_LAS bf16x8*)(lds + PG8_SA(b, h) + aoff + m * 2048 + k * 1024); } while (0)
#define PG8_LDB(dst, b, h) do { _Pragma("unroll") for (int n = 0; n < 2; ++n) _Pragma("unroll") for (int k = 0; k < 2; ++k) dst[n][k] = *(const PG8_LAS bf16x8*)(lds + PG8_SB(b, h) + boff + n * 2048 + k * 1024); } while (0)
#define PG8_MMA(ai, bj, At, Bt) do { __builtin_amdgcn_s_setprio(1); _Pragma("unroll") for (int m = 0; m < 4; ++m) _Pragma("unroll") for (int n = 0; n < 2; ++n) _Pragma("unroll") for (int k = 0; k < 2; ++k) \
        acc[ai][bj][m][n] = __builtin_amdgcn_mfma_f32_16x16x32_bf16(Bt[n][k], At[m][k], acc[ai][bj][m][n], 0, 0, 0); __builtin_amdgcn_s_setprio(0); } while (0)
#define PG8_WAIT_V(n) asm volatile("s_waitcnt vmcnt(" #n ")" ::: "memory")
#define PG8_WAIT_L(n) asm volatile("s_waitcnt lgkmcnt(" #n ")" ::: "memory")
#define PG8_BAR __builtin_amdgcn_s_barrier()
#define PG8_SCHED __builtin_amdgcn_sched_barrier(0)
    Unit cur, nxt; int ui = 0;
    if (!S.next(0, cur)) return;
    f32x4 acc[2][2][4][2];
#pragma unroll
    for (int a = 0; a < 2; ++a)
#pragma unroll
        for (int b = 0; b < 2; ++b)
#pragma unroll
            for (int m = 0; m < 4; ++m)
#pragma unroll
                for (int n = 0; n < 2; ++n) acc[a][b][m][n] = (f32x4){0.f, 0.f, 0.f, 0.f};
    bf16x8 At[4][2], B0[2][2], B1[2][2];
    const char* cA = (const char*)g.A + (size_t)cur.pm * tstepA; const char* cB = (const char*)g.Bt + (size_t)cur.pn * tstepB;
    S.a_ready(cur);
    if constexpr (SP2) {
        PG8_STAGE(PG8_SB(0, 0), cB, voffB); PG8_STAGE(PG8_SB(0, 1), cB + hstepB, voffB); PG8_STAGE(PG8_SA(0, 0), cA, voffA); PG8_STAGE(PG8_SA(0, 1), cA + hstepA, voffA);
        if (wr == 1) PG8_BAR;
        PG8_WAIT_V(2); PG8_BAR;
        PG8_STAGE(PG8_SB(1, 0), cB + kstep, voffB); PG8_STAGE(PG8_SA(1, 0), cA + kstep, voffA); PG8_STAGE(PG8_SB(1, 1), cB + hstepB + kstep, voffB);
        PG8_WAIT_V(6); PG8_BAR;
    } else {
        PG8_STAGE(PG8_SB(0, 0), cB, voffB); PG8_STAGE(PG8_SA(0, 0), cA, voffA); PG8_STAGE(PG8_SB(0, 1), cB + hstepB, voffB); PG8_STAGE(PG8_SA(0, 1), cA + hstepA, voffA);
        if (wr == 1) PG8_BAR;
        PG8_WAIT_V(4); PG8_BAR;
        PG8_STAGE(PG8_SB(1, 0), cB + kstep, voffB); PG8_STAGE(PG8_SA(1, 0), cA + kstep, voffA); PG8_STAGE(PG8_SB(1, 1), cB + hstepB + kstep, voffB);
        PG8_WAIT_V(6); PG8_BAR;
    }
    for (;;) {
        const bool has_next = S.next(ui + 1, nxt);
        const char* nA = has_next ? (const char*)g.A + (size_t)nxt.pm * tstepA : cA; const char* nB = has_next ? (const char*)g.Bt + (size_t)nxt.pn * tstepB : cB;
        for (int t = 0; t < nt; t += 2) {
            const bool last = (t == nt - 2);
            const char* a1 = cA + (size_t)(t + 1) * kstep;
            const char* a2 = last ? nA : cA + (size_t)(t + 2) * kstep; const char* b2 = last ? nB : cB + (size_t)(t + 2) * kstep;
            const char* a3 = a2 + kstep; const char* b3 = b2 + kstep;
            if (last && has_next) S.a_ready(nxt);
            if constexpr (SP2) {
            PG8_LDB(B0, 0, 0); PG8_LDB(B1, 0, 1); PG8_SCHED; PG8_LDA(At, 0, 0); PG8_STAGE(PG8_SA(1, 1), a1 + hstepA, voffA);
            PG8_WAIT_V(8); PG8_WAIT_L(0); PG8_BAR; PG8_MMA(0, 0, At, B0); PG8_MMA(0, 1, At, B1); PG8_BAR; PG8_SCHED;
            PG8_LDA(At, 0, 1); PG8_STAGE(PG8_SB(0, 0), b2, voffB); PG8_STAGE(PG8_SB(0, 1), b2 + hstepB, voffB); PG8_STAGE(PG8_SA(0, 0), a2, voffA);
            PG8_WAIT_V(8); PG8_WAIT_L(0); PG8_BAR; PG8_MMA(1, 0, At, B0); PG8_MMA(1, 1, At, B1); PG8_BAR; PG8_SCHED;
            PG8_LDB(B0, 1, 0); PG8_LDB(B1, 1, 1); PG8_SCHED; PG8_LDA(At, 1, 0); PG8_STAGE(PG8_SA(0, 1), a2 + hstepA, voffA);
            PG8_WAIT_V(8); PG8_WAIT_L(0); PG8_BAR; PG8_MMA(0, 0, At, B0); PG8_MMA(0, 1, At, B1); PG8_BAR; PG8_SCHED;
            PG8_LDA(At, 1, 1); PG8_STAGE(PG8_SB(1, 0), b3, voffB); PG8_STAGE(PG8_SB(1, 1), b3 + hstepB, voffB); PG8_STAGE(PG8_SA(1, 0), a3, voffA);
            PG8_WAIT_V(8); PG8_WAIT_L(0); PG8_BAR; PG8_MMA(1, 0, At, B0); PG8_MMA(1, 1, At, B1); PG8_BAR; PG8_SCHED;
            } else {
            PG8_LDB(B0, 0, 0); PG8_SCHED; PG8_LDA(At, 0, 0); PG8_STAGE(PG8_SA(1, 1), a1 + hstepA, voffA);
            PG8_WAIT_L(8); PG8_BAR; PG8_WAIT_L(0); PG8_MMA(0, 0, At, B0); PG8_BAR; PG8_SCHED;
            PG8_LDB(B1, 0, 1); PG8_STAGE(PG8_SB(0, 0), b2, voffB);
            PG8_BAR; PG8_WAIT_L(0); PG8_MMA(0, 1, At, B1); PG8_BAR;
            PG8_LDA(At, 0, 1); PG8_STAGE(PG8_SA(0, 0), a2, voffA);
            PG8_BAR; PG8_WAIT_L(0); PG8_MMA(1, 0, At, B0); PG8_BAR; PG8_SCHED;
            PG8_STAGE(PG8_SB(0, 1), b2 + hstepB, voffB);
            PG8_WAIT_V(6); PG8_BAR; PG8_MMA(1, 1, At, B1); PG8_BAR;
            PG8_LDB(B0, 1, 0); PG8_SCHED; PG8_LDA(At, 1, 0); PG8_STAGE(PG8_SA(0, 1), a2 + hstepA, voffA);
            PG8_WAIT_L(8); PG8_BAR; PG8_WAIT_L(0); PG8_MMA(0, 0, At, B0); PG8_BAR; PG8_SCHED;
            PG8_LDB(B1, 1, 1); PG8_STAGE(PG8_SB(1, 0), b3, voffB);
            PG8_BAR; PG8_WAIT_L(0); PG8_MMA(0, 1, At, B1); PG8_BAR;
            PG8_LDA(At, 1, 1); PG8_STAGE(PG8_SA(1, 0), a3, voffA);
            PG8_BAR; PG8_WAIT_L(0); PG8_MMA(1, 0, At, B0); PG8_BAR; PG8_SCHED;
            PG8_STAGE(PG8_SB(1, 1), b3 + hstepB, voffB);
            PG8_WAIT_V(6); PG8_BAR; PG8_MMA(1, 1, At, B1); PG8_BAR;
            }
        }
        if constexpr (ALIGN_EPI) { if (wr == 0) PG8_BAR; }
        if constexpr (!Epi::AFTER_DRAIN) { E(acc, cur, wr, wc, fr, fq); S.done(cur); }
        if (!has_next) break;
#pragma unroll
        for (int a = 0; a < 2; ++a)
#pragma unroll
            for (int b = 0; b < 2; ++b)
#pragma unroll
                for (int m = 0; m < 4; ++m)
#pragma unroll
                    for (int n = 0; n < 2; ++n) acc[a][b][m][n] = (f32x4){0.f, 0.f, 0.f, 0.f};
        cur = nxt; cA = nA; cB = nB; ++ui;
        if constexpr (ALIGN_EPI) { if (wr == 1) PG8_BAR; }
    }
    PG8_WAIT_V(0);
    if constexpr (!ALIGN_EPI) { if (wr == 0) PG8_BAR; }
    PG8_BAR;
    if constexpr (Epi::AFTER_DRAIN) { E.fused(acc, cur, wr, wc, fr, fq, lds, wid, lane); S.done(cur); }
#undef PG8_SA
#undef PG8_SB
#undef PG8_STAGE
#undef PG8_LDA
#undef PG8_LDB
#undef PG8_MMA
#undef PG8_WAIT_V
#undef PG8_WAIT_L
#undef PG8_BAR
#undef PG8_SCHED
}
}
#define LAS __attribute__((address_space(3)))
#define GASA __attribute__((address_space(1)))
typedef unsigned short bf16_t;
typedef short bf16x8 __attribute__((ext_vector_type(8)));
typedef short s16x4 __attribute__((ext_vector_type(4)));
typedef float f32x4 __attribute__((ext_vector_type(4)));
typedef float f32x2 __attribute__((ext_vector_type(2)));
typedef float f32x16 __attribute__((ext_vector_type(16)));
typedef unsigned u32x4 __attribute__((ext_vector_type(4)));
typedef unsigned u32x2 __attribute__((ext_vector_type(2)));
typedef __bf16 bf16x2_t __attribute__((ext_vector_type(2)));
#define DI __device__ __forceinline__
DI unsigned pk2(float lo, float hi) { f32x2 v = {lo, hi}; bf16x2_t b = __builtin_convertvector(v, bf16x2_t); return __builtin_bit_cast(unsigned, b); }
DI float bflo(unsigned w) { return __uint_as_float(w << 16); }
DI float bfhi(unsigned w) { return __uint_as_float(w & 0xffff0000u); }
DI void unpack8(const u32x4 w, float* x) { x[0] = bflo(w.x); x[1] = bfhi(w.x); x[2] = bflo(w.y); x[3] = bfhi(w.y); x[4] = bflo(w.z); x[5] = bfhi(w.z); x[6] = bflo(w.w); x[7] = bfhi(w.w); }
DI u32x4 pack8(const float* x) { u32x4 w; w.x = pk2(x[0], x[1]); w.y = pk2(x[2], x[3]); w.z = pk2(x[4], x[5]); w.w = pk2(x[6], x[7]); return w; }
DI float wave_sum(float v) {
#pragma unroll
    for (int o = 1; o < 64; o <<= 1) v += __shfl_xor(v, o);
    return v;
}
constexpr float NORM_EPS = 1e-6f;
constexpr float LOG2E = 1.4426950408889634f;

struct AttnArgs {
    const bf16_t* q; long qs;
    const bf16_t* k; long ks;
    const bf16_t* k2; long k2s;
    const bf16_t* v; long vs;
    bf16_t* o; long os;
    float* lse; long lses;
    int kv_len, q0;
    int nomax;
};
DI int crow(int r, int hi) { return (r & 3) + 8 * (r >> 2) + 4 * hi; }
#define MFMA32(a, b, c) __builtin_amdgcn_mfma_f32_32x32x16_bf16((a), (b), (c), 0, 0, 0)
typedef short v4i16_t __attribute__((ext_vector_type(4)));
DI s16x4 vtr(const LAS unsigned char* p) { return __builtin_bit_cast(s16x4, __builtin_amdgcn_ds_read_tr16_b64_v4i16((LAS v4i16_t*)p)); }

DI void glds16(const void* gsrc, unsigned lds_dst) { unsigned keep;
    asm volatile("s_mov_b32 %0, m0\n\ts_mov_b32 m0, %2\n\ts_nop 0\n\tglobal_load_lds_dwordx4 %1, off\n\ts_mov_b32 m0, %0" : "=&s"(keep) : "v"(gsrc), "s"(lds_dst) : "memory"); }
template <int DQK, int DV, bool BAND>
DI void attn_unit(const AttnArgs& a, LAS unsigned char* lds, int tid) {
    constexpr int NKP = DQK / 8, NVP = DV / 8;
    constexpr int NKI = (NKP + 7) / 8, NVI = NVP / 8;
    constexpr int NLD = NKI + NVI;
    constexpr int ND0 = DQK / 16, NDB = DV / 32, KG = DQK > 96 ? 1 : 4;
    constexpr int KBUF = 0, VBUF = 49152, SCR = 98304;
    const int lane = tid & 63, wid = __builtin_amdgcn_readfirstlane(tid >> 6), r32 = lane & 31, hi = lane >> 5;
    LAS float* scr = (LAS float*)(lds + SCR + wid * 256);
    const unsigned lds0 = (unsigned)(uintptr_t)lds;
    bf16x8 qf[ND0];
    { const GASA bf16_t* qrow = (const GASA bf16_t*)a.q + (long)(wid * 32 + r32) * a.qs;
#pragma unroll
      for (int d0 = 0; d0 < ND0; ++d0) qf[d0] = *(const GASA bf16x8*)(qrow + d0 * 16 + hi * 8); }
#pragma unroll
    for (int d0 = 0; d0 < ND0; ++d0) asm volatile("" : "+v"(qf[d0]));
    asm volatile("s_waitcnt vmcnt(0)" ::: "memory");
    int t_lo = 0, t_hi = a.kv_len >> 6;
    if (BAND) { const int tb = (a.q0 >> 6) - 1; t_lo = tb < 0 ? 0 : tb; const int te = (a.q0 >> 6) + 5; t_hi = te < t_hi ? te : t_hi; }
    const int qw = a.q0 + wid * 32;
#define AT_DMA(t, so_) do { \
    _Pragma("unroll") for (int i_ = 0; i_ < NKI; ++i_) { const int pl_ = (wid + 8 * i_ < NKP) ? wid + 8 * i_ : wid; const long key_ = (long)(t) * 64 + lane; \
        const bf16_t* s_ = (DQK == 96 && pl_ >= 8) ? a.k2 + key_ * a.k2s + (pl_ - 8) * 8 : a.k + key_ * a.ks + pl_ * 8; \
        glds16(s_, (unsigned)__builtin_amdgcn_readfirstlane(lds0 + KBUF + (so_) + pl_ * 1024)); } \
    _Pragma("unroll") for (int i_ = 0; i_ < NVI; ++i_) { const int pc_ = wid + 8 * i_; const long row_ = (long)(t) * 64 + 16 * (pc_ & 3) + (lane >> 2); \
        glds16(a.v + row_ * a.vs + (pc_ >> 2) * 32 + (lane & 3) * 8, (unsigned)__builtin_amdgcn_readfirstlane(lds0 + VBUF + (so_) + pc_ * 1024)); } } while (0)
#define AT_WAITBAR(N) asm volatile("s_waitcnt vmcnt(%0) lgkmcnt(0)\n\ts_barrier" :: "n"(N) : "memory")
#define AT_PV(vs_) do { \
    const LAS unsigned char* vp_ = lds + VBUF + (vs_) + ((lane >> 4) & 1) * 32 + (lane & 3) * 8 + (4 * hi + ((lane & 15) >> 2)) * 64; \
    _Pragma("unroll") for (int ks = 0; ks < 4; ++ks) { \
        _Pragma("unroll") for (int d = 0; d < NDB; ++d) { \
            const s16x4 lo = vtr(vp_ + d * 4096 + ks * 1024), hh = vtr(vp_ + d * 4096 + ks * 1024 + 512); \
            const bf16x8 vf = (bf16x8){lo[0], lo[1], lo[2], lo[3], hh[0], hh[1], hh[2], hh[3]}; \
            o[d] = MFMA32(pa[ks], vf, o[d]); } \
        lacc = MFMA32(pa[ks], ones, lacc); } } while (0)
    if (wid >= 4) __builtin_amdgcn_s_setprio(1);
    f32x16 o[NDB], lacc, negm;
#pragma unroll
    for (int d = 0; d < NDB; ++d)
#pragma unroll
        for (int r = 0; r < 16; ++r) o[d][r] = 0.f;
#pragma unroll
    for (int r = 0; r < 16; ++r) { lacc[r] = 0.f; negm[r] = 0.f; }
    float m_run = 0.f; bool first = true;
    const bf16x8 ones = (bf16x8){(short)0x3F80, (short)0x3F80, (short)0x3F80, (short)0x3F80, (short)0x3F80, (short)0x3F80, (short)0x3F80, (short)0x3F80};
    if (BAND) {
        for (int t = t_lo; t < t_hi; ++t) AT_DMA(t, (t - t_lo) * 8192);
        AT_WAITBAR(0);
    } else {
        AT_DMA(t_lo, 0);
        if (t_lo + 1 < t_hi) AT_DMA(t_lo + 1, 16384);
    }
    int vcur = 0;
    bf16x8 pa[4];
    for (int t = t_lo; t < t_hi; ++t) {
        int vnext = 0;
        if (BAND) { vcur = (t - t_lo) * 8192; }
        else {
            if (t + 1 < t_hi) AT_WAITBAR(NLD); else AT_WAITBAR(0);
            vnext = vcur == 32768 ? 0 : vcur + 16384; const int vnn = vnext == 32768 ? 0 : vnext + 16384;
            if (t + 2 < t_hi) AT_DMA(t + 2, vnn);
        }
        bool active = true;
        if (BAND) active = (64 * t + 63 >= qw - 64) && (64 * t <= qw + 95);
        if (active) {
            f32x16 p0, p1;
            const LAS unsigned char* kb = lds + KBUF + vcur + hi * 1024 + r32 * 16;
#pragma unroll
            for (int dg = 0; dg < ND0; dg += KG) {
                bf16x8 kf0[KG], kf1[KG];
#pragma unroll
                for (int j = 0; j < KG; ++j) if (dg + j < ND0) { kf0[j] = *(const LAS bf16x8*)(kb + (dg + j) * 2048); kf1[j] = *(const LAS bf16x8*)(kb + (dg + j) * 2048 + 512); }
                __builtin_amdgcn_sched_barrier(0);
#pragma unroll
                for (int j = 0; j < KG; ++j) if (dg + j < ND0) {
                    if (dg + j == 0) { p0 = MFMA32(kf0[j], qf[0], negm); p1 = MFMA32(kf1[j], qf[0], negm); }
                    else { p0 = MFMA32(kf0[j], qf[dg + j], p0); p1 = MFMA32(kf1[j], qf[dg + j], p1); }
                }
            }
            s16x4 vlo[8], vhi[8];
            if (NDB <= 2) { const LAS unsigned char* vp_ = lds + VBUF + vcur + ((lane >> 4) & 1) * 32 + (lane & 3) * 8 + (4 * hi + ((lane & 15) >> 2)) * 64;
#pragma unroll
              for (int d = 0; d < 2; ++d)
#pragma unroll
                  for (int ks = 0; ks < 4; ++ks) { vlo[d * 4 + ks] = vtr(vp_ + d * 4096 + ks * 1024); vhi[d * 4 + ks] = vtr(vp_ + d * 4096 + ks * 1024 + 512); } }
            __builtin_amdgcn_sched_barrier(0);
            if (BAND) { const int qi = qw + r32; const int kb0 = 64 * t + 4 * hi;
#pragma unroll
                for (int r = 0; r < 16; ++r) { const int kv = kb0 + (r & 3) + 8 * (r >> 2); int d = qi - kv; d = d < 0 ? -d : d; if (d > 64) p0[r] = -1e30f; int d2 = qi - kv - 32; d2 = d2 < 0 ? -d2 : d2; if (d2 > 64) p1[r] = -1e30f; } }
            if (!a.nomax) {
            float mx = fmaxf(p0[0], p1[0]);
#pragma unroll
            for (int r = 1; r < 16; ++r) mx = fmaxf(fmaxf(mx, p0[r]), p1[r]);
            { const unsigned mu = __float_as_uint(mx); auto rr = __builtin_amdgcn_permlane32_swap(mu, mu, false, false); mx = fmaxf(__uint_as_float(rr[0]), __uint_as_float(rr[1])); }
            if (first || __any(mx > 8.0f)) {
                const float delta = first ? fmaxf(mx, -1e4f) : fmaxf(mx, 0.f);
                m_run += delta;
#pragma unroll
                for (int r = 0; r < 16; ++r) { p0[r] -= delta; p1[r] -= delta; negm[r] = -m_run; }
                if (!first) {
                    const float alpha = __builtin_amdgcn_exp2f(-delta);
                    if (hi == 0) scr[r32] = alpha;
#pragma unroll
                    for (int g = 0; g < 4; ++g) { const f32x4 al = *(const LAS f32x4*)(scr + 8 * g + 4 * hi);
                        lacc[4 * g] *= al.x; lacc[4 * g + 1] *= al.y; lacc[4 * g + 2] *= al.z; lacc[4 * g + 3] *= al.w;
#pragma unroll
                        for (int d = 0; d < NDB; ++d) { o[d][4 * g] *= al.x; o[d][4 * g + 1] *= al.y; o[d][4 * g + 2] *= al.z; o[d][4 * g + 3] *= al.w; } }
                }
                first = false;
            }
            }
#pragma unroll
            for (int r = 0; r < 16; ++r) { p0[r] = __builtin_amdgcn_exp2f(p0[r]); p1[r] = __builtin_amdgcn_exp2f(p1[r]); }
            { u32x4 w;
              w.x = pk2(p0[0], p0[1]); w.y = pk2(p0[2], p0[3]); w.z = pk2(p0[4], p0[5]); w.w = pk2(p0[6], p0[7]); pa[0] = __builtin_bit_cast(bf16x8, w);
              w.x = pk2(p0[8], p0[9]); w.y = pk2(p0[10], p0[11]); w.z = pk2(p0[12], p0[13]); w.w = pk2(p0[14], p0[15]); pa[1] = __builtin_bit_cast(bf16x8, w);
              w.x = pk2(p1[0], p1[1]); w.y = pk2(p1[2], p1[3]); w.z = pk2(p1[4], p1[5]); w.w = pk2(p1[6], p1[7]); pa[2] = __builtin_bit_cast(bf16x8, w);
              w.x = pk2(p1[8], p1[9]); w.y = pk2(p1[10], p1[11]); w.z = pk2(p1[12], p1[13]); w.w = pk2(p1[14], p1[15]); pa[3] = __builtin_bit_cast(bf16x8, w); }
            if (DQK > 96) { AT_PV(vcur); } else {
                if (NDB > 2) { const LAS unsigned char* vp_ = lds + VBUF + vcur + ((lane >> 4) & 1) * 32 + (lane & 3) * 8 + (4 * hi + ((lane & 15) >> 2)) * 64;
#pragma unroll
                    for (int d = 0; d < 2; ++d)
#pragma unroll
                        for (int ks = 0; ks < 4; ++ks) { vlo[d * 4 + ks] = vtr(vp_ + d * 4096 + ks * 1024); vhi[d * 4 + ks] = vtr(vp_ + d * 4096 + ks * 1024 + 512); }
                    __builtin_amdgcn_sched_barrier(0); }
#pragma unroll
                for (int ks = 0; ks < 4; ++ks) {
#pragma unroll
                    for (int d = 0; d < 2; ++d) { const s16x4 lo = vlo[d * 4 + ks], hh = vhi[d * 4 + ks];
                        const bf16x8 vf = (bf16x8){lo[0], lo[1], lo[2], lo[3], hh[0], hh[1], hh[2], hh[3]}; o[d] = MFMA32(pa[ks], vf, o[d]); }
                    lacc = MFMA32(pa[ks], ones, lacc); }
                if (NDB > 2) {
                    const LAS unsigned char* vp_ = lds + VBUF + vcur + ((lane >> 4) & 1) * 32 + (lane & 3) * 8 + (4 * hi + ((lane & 15) >> 2)) * 64;
#pragma unroll
                    for (int d = 2; d < NDB; ++d)
#pragma unroll
                        for (int ks = 0; ks < 4; ++ks) { vlo[(d - 2) * 4 + ks] = vtr(vp_ + d * 4096 + ks * 1024); vhi[(d - 2) * 4 + ks] = vtr(vp_ + d * 4096 + ks * 1024 + 512); }
                    __builtin_amdgcn_sched_barrier(0);
#pragma unroll
                    for (int ks = 0; ks < 4; ++ks)
#pragma unroll
                        for (int d = 2; d < NDB; ++d) { const s16x4 lo = vlo[(d - 2) * 4 + ks], hh = vhi[(d - 2) * 4 + ks];
                            const bf16x8 vf = (bf16x8){lo[0], lo[1], lo[2], lo[3], hh[0], hh[1], hh[2], hh[3]}; o[d] = MFMA32(pa[ks], vf, o[d]); }
                }
            }
        }
        if (!BAND) vcur = vnext;
    }
    asm volatile("s_waitcnt lgkmcnt(0)\n\ts_barrier" ::: "memory");
    __builtin_amdgcn_s_setprio(0);
    { if (a.lse != nullptr) {
          if (hi == 0) scr[r32] = m_run;
#pragma unroll
          for (int g = 0; g < 4; ++g) { const f32x4 mr = *(const LAS f32x4*)(scr + 8 * g + 4 * hi);
#pragma unroll
              for (int e = 0; e < 4; ++e) if (r32 == 0) ((GASA float*)a.lse)[(long)(wid * 32 + 8 * g + 4 * hi + e) * a.lses] = mr[e] + __builtin_amdgcn_logf(lacc[4 * g + e]); } }
      LAS bf16_t* stg = (LAS bf16_t*)(lds + wid * 8192);
#pragma unroll
      for (int g = 0; g < 4; ++g) {
#pragma unroll
          for (int e = 0; e < 4; ++e) { const int orow = 8 * g + 4 * hi + e; const float rr = __builtin_amdgcn_rcpf(lacc[4 * g + e]);
#pragma unroll
              for (int d = 0; d < NDB; ++d) stg[orow * DV + d * 32 + r32] = (bf16_t)(pk2(o[d][4 * g + e] * rr, 0.f) & 0xffffu); } }
      constexpr int CPR = DV / 8, RPI = 64 / CPR;
#pragma unroll
      for (int i = 0; i < 32 / RPI; ++i) { const int row = i * RPI + lane / CPR, ch = lane % CPR;
          const u32x4 v = *(const LAS u32x4*)(stg + row * DV + ch * 8); *(GASA u32x4*)((GASA bf16_t*)a.o + (long)(wid * 32 + row) * a.os + ch * 8) = v; }
    }
    __syncthreads();
#undef AT_DMA
#undef AT_WAITBAR
#undef AT_PV
}
constexpr int DM = 1024, TC = 16384, NCH = 3, DEPTH = 4, FF = 4096, NTOK = 49152, NMEMROWS = 2560;
constexpr size_t MiB = 1u << 20;
constexpr size_t WL_XQ = 0, WL_XKV = WL_XQ + 512 * 1024, WL_XO = WL_XKV + 1024 * 1024, WL_MI = WL_XO + 1024 * 512, WL_MO = WL_MI + 4096 * 1024, WL_SZ = WL_MO + 1024 * 4096;
constexpr size_t W_A_IN = 4 * WL_SZ, W_A_OUT = W_A_IN + 4608 * 1024, W_B_IN = W_A_OUT + 1024 * 512, W_B_OUT = W_B_IN + 1536 * 1024, W_C_IN = W_B_OUT + 1024 * 1024,
                 W_C_OUT = W_C_IN + 3072 * 1024, W_D_IN = W_C_OUT + 1024 * 1024, W_D_UQ = W_D_IN + 768 * 1024, W_D_UKV = W_D_UQ + 1536 * 384, W_D_OUT = W_D_UKV + 2048 * 256, W_END = W_D_OUT + 1024 * 1024;
constexpr size_t WS_CTL = 0, WS_W = 2 * MiB, WS_TAB = 112 * MiB, WS_MN = 114 * MiB, WS_KVM = 134 * MiB, WS_H = 154 * MiB, WS_AO = 186 * MiB, WS_LSE = 218 * MiB,
                 WS_BIG = 220 * MiB, WS_X2 = 380 * MiB, WS_SS = 396 * MiB, WS_END = 404 * MiB;
constexpr size_t SS_BYTES = (size_t)NCH * 5 * 3 * TC * 8;
static_assert(WS_SS + SS_BYTES <= WS_END, "ss fits");
static_assert(WS_W + W_END * 2 <= WS_TAB, "weights fit");
constexpr size_t TAB_A = WS_TAB, TAB_B = WS_TAB + 512 * 1024, TAB_D = WS_TAB + MiB;
constexpr int LDS_BYTES = 131072 + 4096;

struct Params {
    const float* in[33]; float* out; unsigned char* ws;
    double invfA[8], invfD[16], invfB[16];
    float lam_init, one_minus_li; int step_lo, step_hi;
};

DI void transpose_item(const float* W, int K, int N, bf16_t* WT, LAS float* scr, int item, int lane, int period, int hi_, float scale, const float* gain) {
    const int nblk = N / 32, kb = item / nblk, nb = item % nblk, k0 = 64 * kb, n0 = 32 * nb;
    const __attribute__((address_space(1))) float* Wg = (const __attribute__((address_space(1))) float*)W + (size_t)(k0 + (lane >> 5)) * N + n0 + (lane & 31);
    float wv[32];
#pragma unroll
    for (int i = 0; i < 32; ++i) wv[i] = Wg[(size_t)(2 * i) * N];
#pragma unroll
    for (int i = 0; i < 32; ++i) { const int kk = 2 * i + (lane >> 5); scr[kk * 33 + (lane & 31)] = wv[i] * (gain ? gain[k0 + kk] : 1.0f); }
    const int c = lane & 7;
#pragma unroll
    for (int j = 0; j < 4; ++j) { const int n = (lane >> 3) + 8 * j; const LAS float* s = scr + (8 * c) * 33 + n;
        const float sc = ((n0 + n) % period) < hi_ ? scale : 1.0f;
        u32x4 o; o.x = pk2(s[0 * 33] * sc, s[1 * 33] * sc); o.y = pk2(s[2 * 33] * sc, s[3 * 33] * sc); o.z = pk2(s[4 * 33] * sc, s[5 * 33] * sc); o.w = pk2(s[6 * 33] * sc, s[7 * 33] * sc);
        *(__attribute__((address_space(1))) u32x4*)((__attribute__((address_space(1))) bf16_t*)WT + (size_t)(n0 + n) * K + k0 + 8 * c) = o; }
}
DI void norm_row_bf16(const float* xrow, const float* gain, bf16_t* orow, int lane) {
    const __attribute__((address_space(1))) f32x4* xr = (const __attribute__((address_space(1))) f32x4*)xrow + lane; const __attribute__((address_space(1))) f32x4* gr = (const __attribute__((address_space(1))) f32x4*)gain + lane;
    f32x4 v[4]; float s = 0.f;
#pragma unroll
    for (int j = 0; j < 4; ++j) { v[j] = xr[64 * j]; s += (v[j].x * v[j].x + v[j].y * v[j].y) + (v[j].z * v[j].z + v[j].w * v[j].w); }
    const float rstd = 1.0f / sqrtf(wave_sum(s) * (1.f / DM) + NORM_EPS);
    __attribute__((address_space(1))) u32x2* o8 = (__attribute__((address_space(1))) u32x2*)orow + lane;
#pragma unroll
    for (int j = 0; j < 4; ++j) { const f32x4 g = gr[64 * j]; u32x2 w; w.x = pk2(v[j].x * rstd * g.x, v[j].y * rstd * g.y); w.y = pk2(v[j].z * rstd * g.z, v[j].w * rstd * g.w); o8[64 * j] = w; }
}
DI void start_row(const float* xrow, bf16_t* brow, unsigned long long* ssp, int lane) {
    const __attribute__((address_space(1))) f32x4* xr = (const __attribute__((address_space(1))) f32x4*)xrow + lane; __attribute__((address_space(1))) u32x2* o8 = (__attribute__((address_space(1))) u32x2*)brow + lane;
    float s = 0.f;
    f32x4 vv[4];
#pragma unroll
    for (int j = 0; j < 4; ++j) vv[j] = xr[64 * j];
#pragma unroll
    for (int j = 0; j < 4; ++j) { const f32x4 v = vv[j]; u32x2 w; w.x = pk2(v.x, v.y); w.y = pk2(v.z, v.w); o8[64 * j] = w;
        const float a = bflo(w.x), b = bfhi(w.x), c = bflo(w.y), d = bfhi(w.y); s += (a * a + b * b) + (c * c + d * d); }
    s = wave_sum(s);
    if (lane == 0) *(__attribute__((address_space(1))) unsigned long long*)ssp = (unsigned long long)(s * 1048576.0f + 0.5f);
}
DI void norm_row_f32_inplace(float* xrow, const float* gain, int lane) {
    f32x4* xr = (f32x4*)xrow + lane; const f32x4* gr = (const f32x4*)gain + lane;
    f32x4 v[4]; float s = 0.f;
#pragma unroll
    for (int j = 0; j < 4; ++j) { v[j] = xr[64 * j]; s += (v[j].x * v[j].x + v[j].y * v[j].y) + (v[j].z * v[j].z + v[j].w * v[j].w); }
    const float rstd = 1.0f / sqrtf(wave_sum(s) * (1.f / DM) + NORM_EPS);
#pragma unroll
    for (int j = 0; j < 4; ++j) { const f32x4 g = gr[64 * j]; xr[64 * j] = (f32x4){v[j].x * rstd * g.x, v[j].y * rstd * g.y, v[j].z * rstd * g.z, v[j].w * rstd * g.w}; }
}
DI void final_row(const bf16_t* brow, float* orow, const float* gain, unsigned long long ssv, int lane) {
    const __attribute__((address_space(1))) u32x2* br = (const __attribute__((address_space(1))) u32x2*)brow + lane; __attribute__((address_space(1))) f32x4* orr = (__attribute__((address_space(1))) f32x4*)orow + lane; const __attribute__((address_space(1))) f32x4* gr = (const __attribute__((address_space(1))) f32x4*)gain + lane;
    const float rstd = 1.0f / sqrtf((float)ssv * (1.0f / (1024.0f * 1048576.0f)) + NORM_EPS);
#pragma unroll
    for (int j = 0; j < 4; ++j) { const u32x2 w = br[64 * j]; const f32x4 g = gr[64 * j]; orr[64 * j] = (f32x4){bflo(w.x) * rstd * g.x, bfhi(w.x) * rstd * g.y, bflo(w.y) * rstd * g.z, bfhi(w.y) * rstd * g.w}; }
}
DI f32x2 cs_of(double pos, double invf) { double rev = pos * invf * 0.15915494309189533577; rev -= __builtin_rint(rev); const float r = (float)rev; return (f32x2){__builtin_amdgcn_cosf(r), __builtin_amdgcn_sinf(r)}; }

DI void prep_rope16(bf16_t* X, int ld, int nvec, int grp_stride, int seq_len, const f32x2* tab, int gtid, int gthreads) {
    const int total = TC * nvec;
    for (int idx = gtid; idx < total; idx += gthreads) {
        const int row = idx / nvec, v = idx - row * nvec; const int pos = row % seq_len;
        bf16_t* p = X + (size_t)row * ld + (v >> 4) * grp_stride + (v & 15) * 64;
        const u32x4 w1 = *(const u32x4*)p, w2 = *(const u32x4*)(p + 8);
        float x1[8], x2[8], y1[8], y2[8]; unpack8(w1, x1); unpack8(w2, x2);
        const f32x4* t4 = (const f32x4*)(tab + (size_t)pos * 8);
#pragma unroll
        for (int i = 0; i < 4; ++i) { const f32x4 cs = t4[i];
            y1[2 * i] = x1[2 * i] * cs.x - x2[2 * i] * cs.y; y2[2 * i] = x2[2 * i] * cs.x + x1[2 * i] * cs.y;
            y1[2 * i + 1] = x1[2 * i + 1] * cs.z - x2[2 * i + 1] * cs.w; y2[2 * i + 1] = x2[2 * i + 1] * cs.z + x1[2 * i + 1] * cs.w; }
        *(u32x4*)p = pack8(y1); *(u32x4*)(p + 8) = pack8(y2);
    }
}
DI void prep_b(bf16_t* X, const float* qg, const float* kg, int seq_len, const f32x2* tabB, int gtid, int gthreads) {
    const int total = TC * 20 * 8;
    for (int idx = gtid; idx < total; idx += gthreads) {
        const int j = idx & 7, vi = idx >> 3; const int row = vi / 20, vv = vi - row * 20;
        bf16_t* p = X + (size_t)row * 1536 + (vv < 16 ? vv * 64 : 1024 + (vv - 16) * 64) + j * 8;
        const __attribute__((address_space(1))) float* g = (const __attribute__((address_space(1))) float*)(vv < 16 ? qg : kg) + j * 8;
        float x[8]; unpack8(*(const __attribute__((address_space(1))) u32x4*)p, x);
        float ss = 0.f;
#pragma unroll
        for (int e = 0; e < 8; ++e) ss += x[e] * x[e];
        ss += __shfl_xor(ss, 1); ss += __shfl_xor(ss, 2); ss += __shfl_xor(ss, 4);
        const float rstd = 1.0f / sqrtf(ss * (1.f / 64.f) + NORM_EPS);
        const int t = row % seq_len; const int pos = (j >> 2) ? (t & 63) : (t >> 6); const int jj = j & 3; const bool first = jj < 2;
        const __attribute__((address_space(1))) f32x2* tb = (const __attribute__((address_space(1))) f32x2*)tabB + pos * 16 + 8 * (jj & 1);
        float y[8];
#pragma unroll
        for (int e = 0; e < 8; ++e) { x[e] = x[e] * rstd * g[e] * (vv < 16 ? 0.125f * LOG2E : 1.0f); }
#pragma unroll
        for (int e = 0; e < 8; ++e) { const float other = __shfl_xor(x[e], 2); const f32x2 cs = tb[e]; y[e] = first ? x[e] * cs.x - other * cs.y : x[e] * cs.x + other * cs.y; }
        *(__attribute__((address_space(1))) u32x4*)p = pack8(y);
    }
}
DI void prep_d1(const bf16_t* cmb, bf16_t* cqn, bf16_t* ckvn, bf16_t* kr, const float* qg, const float* kvg, int seq_len, const f32x2* tabD, int gw, int ngw, int lane) {
    for (int row = gw; row < TC; row += ngw) {
        const __attribute__((address_space(1))) bf16_t* src = (const __attribute__((address_space(1))) bf16_t*)cmb + (size_t)row * 768;
        float xa[8], xb[8]; unpack8(*(const __attribute__((address_space(1))) u32x4*)(src + 8 * lane), xa);
        if (lane < 20) unpack8(*(const __attribute__((address_space(1))) u32x4*)(src + 8 * (lane + 64)), xb); else {
#pragma unroll
            for (int e = 0; e < 8; ++e) xb[e] = 0.f; }
        float sa = 0.f, sb = 0.f;
#pragma unroll
        for (int e = 0; e < 8; ++e) { sa += xa[e] * xa[e]; sb += xb[e] * xb[e]; }
        const float sq = wave_sum(lane < 48 ? sa : 0.f), skv = wave_sum((lane >= 48 ? sa : 0.f) + (lane < 16 ? sb : 0.f));
        const float rq = 1.0f / sqrtf(sq * (1.f / 384.f) + NORM_EPS), rkv = 1.0f / sqrtf(skv * (1.f / 256.f) + NORM_EPS);
        float y[8];
        if (lane < 48) {
#pragma unroll
            for (int e = 0; e < 8; ++e) y[e] = xa[e] * rq * qg[8 * lane + e];
            *(__attribute__((address_space(1))) u32x4*)((__attribute__((address_space(1))) bf16_t*)cqn + (size_t)row * 384 + 8 * lane) = pack8(y);
        } else {
#pragma unroll
            for (int e = 0; e < 8; ++e) y[e] = xa[e] * rkv * kvg[8 * (lane - 48) + e];
            *(__attribute__((address_space(1))) u32x4*)((__attribute__((address_space(1))) bf16_t*)ckvn + (size_t)row * 256 + 8 * (lane - 48)) = pack8(y);
        }
        if (lane < 16) {
#pragma unroll
            for (int e = 0; e < 8; ++e) y[e] = xb[e] * rkv * kvg[128 + 8 * lane + e];
            *(__attribute__((address_space(1))) u32x4*)((__attribute__((address_space(1))) bf16_t*)ckvn + (size_t)row * 256 + 128 + 8 * lane) = pack8(y);
        }
        const int pos = row % seq_len; const int jj = (lane - 16) & 3; const bool first = jj < 2;
        const f32x2* tb = tabD + (size_t)pos * 16 + 8 * (jj & 1);
#pragma unroll
        for (int e = 0; e < 8; ++e) { const float other = __shfl_xor(xb[e], 2); const f32x2 cs = tb[e]; y[e] = first ? xb[e] * cs.x - other * cs.y : xb[e] * cs.x + other * cs.y; }
        if (lane >= 16 && lane < 20) *(__attribute__((address_space(1))) u32x4*)((__attribute__((address_space(1))) bf16_t*)kr + (size_t)row * 32 + 8 * jj) = pack8(y);
    }
}
DI void prep_d2(bf16_t* Q, int seq_len, const f32x2* tabD, int gtid, int gthreads) {
    for (int idx = gtid; idx < TC * 16; idx += gthreads) {
        const int row = idx >> 4, h = idx & 15; const int pos = row % seq_len;
        bf16_t* p = Q + (size_t)row * 1536 + h * 96 + 64;
        const f32x2* tb = tabD + (size_t)pos * 16;
#pragma unroll
        for (int half = 0; half < 2; ++half) {
            float x1[8], x2[8], y1[8], y2[8]; unpack8(*(const u32x4*)(p + 8 * half), x1); unpack8(*(const u32x4*)(p + 16 + 8 * half), x2);
#pragma unroll
            for (int e = 0; e < 8; ++e) { const f32x2 cs = tb[8 * half + e]; y1[e] = x1[e] * cs.x - x2[e] * cs.y; y2[e] = x2[e] * cs.x + x1[e] * cs.y; }
            *(u32x4*)(p + 8 * half) = pack8(y1); *(u32x4*)(p + 16 + 8 * half) = pack8(y2);
        }
    }
}
DI void merge_a(const bf16_t* QKV, const float* LSE, bf16_t* AO, int gtid, int gthreads) {
    for (int idx = gtid; idx < TC * 64; idx += gthreads) {
        const int j = idx & 7, h = (idx >> 3) & 7, row = idx >> 6;
        const __attribute__((address_space(1))) float* LSEg = (const __attribute__((address_space(1))) float*)LSE; const float l0 = LSEg[((size_t)0 * TC + row) * 8 + h], l1 = LSEg[((size_t)1 * TC + row) * 8 + h], l2 = LSEg[((size_t)2 * TC + row) * 8 + h];
        const float m = fmaxf(l0, fmaxf(l1, l2));
        float w0 = __builtin_amdgcn_exp2f(l0 - m), w1 = __builtin_amdgcn_exp2f(l1 - m), w2 = __builtin_amdgcn_exp2f(l2 - m);
        const float inv = 1.0f / (w0 + w1 + w2); w0 *= inv; w1 *= inv; w2 *= inv;
        const __attribute__((address_space(1))) bf16_t* p = (const __attribute__((address_space(1))) bf16_t*)QKV + (size_t)row * 4608 + h * 64 + j * 8;
        float a[8], b[8], cc[8], y[8]; unpack8(*(const __attribute__((address_space(1))) u32x4*)p, a); unpack8(*(const __attribute__((address_space(1))) u32x4*)(p + 1536), b); unpack8(*(const __attribute__((address_space(1))) u32x4*)(p + 3072), cc);
#pragma unroll
        for (int e = 0; e < 8; ++e) y[e] = w0 * a[e] + w1 * b[e] + w2 * cc[e];
        *(__attribute__((address_space(1))) u32x4*)((__attribute__((address_space(1))) bf16_t*)AO + (size_t)row * 512 + h * 64 + j * 8) = pack8(y);
    }
}
DI void combine_c(const bf16_t* OC, bf16_t* AO, const float* sub_gain, float lam, float oml, int gtid, int gthreads) {
    for (int idx = gtid; idx < TC * 128; idx += gthreads) {
        const int j = idx & 15, h = (idx >> 4) & 7, row = idx >> 7;
        const __attribute__((address_space(1))) bf16_t* p = (const __attribute__((address_space(1))) bf16_t*)OC + (size_t)row * 2048 + h * 256 + j * 8;
        float a[8], b[8], y[8]; unpack8(*(const __attribute__((address_space(1))) u32x4*)p, a); unpack8(*(const __attribute__((address_space(1))) u32x4*)(p + 128), b);
        float ss = 0.f;
#pragma unroll
        for (int e = 0; e < 8; ++e) { a[e] = a[e] - lam * b[e]; ss += a[e] * a[e]; }
        ss += __shfl_xor(ss, 1); ss += __shfl_xor(ss, 2); ss += __shfl_xor(ss, 4); ss += __shfl_xor(ss, 8);
        const float rstd = 1.0f / sqrtf(ss * (1.f / 128.f) + NORM_EPS) * oml;
#pragma unroll
        for (int e = 0; e < 8; ++e) y[e] = a[e] * rstd * sub_gain[8 * j + e];
        *(__attribute__((address_space(1))) u32x4*)((__attribute__((address_space(1))) bf16_t*)AO + (size_t)row * 1024 + h * 128 + j * 8) = pack8(y);
    }
}
#define XB_TMO      128
#define XB_XCNT(j)  (256  + 64 * (j))
#define XB_XSUB(j)  (1280 + 64 * (j))
#define XB_XGEN(j)  (2304 + 64 * (j))
#define XB_TOP      3328
#define XB_TOPGEN   3392
#define XCD_BAR_WORDS 3456
#define XB_SPIN_CAP (1u << 18)

__device__ __forceinline__ unsigned xb_ld(unsigned* p)              { return __hip_atomic_load(p, __ATOMIC_RELAXED, __HIP_MEMORY_SCOPE_AGENT); }
__device__ __forceinline__ unsigned xb_add(unsigned* p, unsigned v) { return __hip_atomic_fetch_add(p, v, __ATOMIC_RELAXED, __HIP_MEMORY_SCOPE_AGENT); }
__device__ __forceinline__ unsigned xb_xcc_id() { return (unsigned)__builtin_amdgcn_s_getreg((3 << 11) | 20) & 0xFu; }
#define XB_SPIN(cond, bar) do { unsigned _sp = 0; while (cond) { __builtin_amdgcn_s_sleep(1); \
    if ((++_sp & 255u) == 0u) { if (xb_ld(&(bar)[XB_TMO])) break; if (_sp > XB_SPIN_CAP) { atomicAdd(&(bar)[XB_TMO], 1u); break; } } } } while (0)

struct XcdBarrier {
    unsigned* bar; unsigned x;
    volatile LAS unsigned* st;
};

__device__ __forceinline__ XcdBarrier xcd_barrier_post(unsigned* bar, volatile LAS unsigned* st) {
    XcdBarrier b; b.bar = bar; b.x = xb_xcc_id(); b.st = st;
    if (threadIdx.x == 0) (void)xb_add(&bar[XB_XCNT(b.x)], 1u);
    return b;
}
__device__ __forceinline__ void xcd_barrier_complete(unsigned* bar, unsigned x, unsigned& nloc, unsigned& nx) {
    const unsigned G = gridDim.x * gridDim.y * gridDim.z;
    unsigned sum, cnt, mine, sp = 0u;
    for (;;) {
        sum = 0u; cnt = 0u; mine = 0u;
#pragma unroll
        for (unsigned j = 0; j < 16; ++j) { const unsigned c = xb_ld(&bar[XB_XCNT(j)]); sum += c; cnt += (c > 0u) ? 1u : 0u; mine = (j == x) ? c : mine; }
        if (sum == G) break;
        __builtin_amdgcn_s_sleep(1);
        if ((++sp & 255u) == 0u) { if (xb_ld(&bar[XB_TMO])) break; if (sp > XB_SPIN_CAP) { atomicAdd(&bar[XB_TMO], 1u); break; } }
    }
    nloc = mine > 0u ? mine : 1u; nx = cnt > 0u ? cnt : 1u;
}

__device__ __forceinline__ void xcd_barrier(const XcdBarrier& b) {
    asm volatile("s_waitcnt vmcnt(0)" ::: "memory");
    __syncthreads();
    if (threadIdx.x == 0) {
        unsigned* bar = b.bar;
        __builtin_amdgcn_s_waitcnt(0);
        unsigned nloc = b.st[0], nx = b.st[1];
        if (nloc == 0u) { xcd_barrier_complete(bar, b.x, nloc, nx); b.st[0] = nloc; b.st[1] = nx; }
        const unsigned old = xb_add(&bar[XB_XSUB(b.x)], 1u);
        const unsigned gen = old / nloc;
        if (old + 1u == (gen + 1u) * nloc) {
            __builtin_amdgcn_fence(__ATOMIC_RELEASE, "agent");
            asm volatile("s_waitcnt vmcnt(0)" ::: "memory");
            const unsigned og = xb_add(&bar[XB_TOP], 1u);
            const unsigned tg = og / nx;
            if (og + 1u == (tg + 1u) * nx) xb_add(&bar[XB_TOPGEN], 1u);
            else XB_SPIN(xb_ld(&bar[XB_TOPGEN]) == tg, bar);
            __builtin_amdgcn_fence(__ATOMIC_ACQUIRE, "agent");
            xb_add(&bar[XB_XGEN(b.x)], 1u);
            asm volatile("s_waitcnt vmcnt(0)" ::: "memory");
        } else {
            XB_SPIN(xb_ld(&bar[XB_XGEN(b.x)]) == gen, bar);
            __builtin_amdgcn_fence(__ATOMIC_ACQUIRE, "agent");
            asm volatile("s_waitcnt vmcnt(0)" ::: "memory");
        }
    }
    __syncthreads();
}
#define GASP __attribute__((address_space(1)))
__global__ void __launch_bounds__(512, 2) mega_fwd(Params p) {
    extern __shared__ __attribute__((aligned(16))) unsigned char lds_raw[];
    LAS unsigned char* lds = (LAS unsigned char*)lds_raw;
    cg::grid_group grid = cg::this_grid();
    if (threadIdx.x < 4) ((LAS unsigned*)(lds + 131072 + 1024))[threadIdx.x] = 0u;
    __syncthreads();
    XcdBarrier xbar = xcd_barrier_post((unsigned*)(p.ws + WS_CTL + 4096), (volatile LAS unsigned*)(lds + 131072 + 1024));
    const int G = gridDim.x, bid = blockIdx.x, ngw = G * 8, gthreads = G * 512;
    int st = 0;
#define PHASE(...) do { if (st >= p.step_lo && st < p.step_hi) { __VA_ARGS__; if (st + 1 < p.step_hi) { if (p.step_hi < 0) grid.sync(); else xcd_barrier(xbar); } } ++st; } while (0)
#define GEMM_STORE(ACT, Aptr, lda_, Bptr, ldb_, M_, N_, K_, Optr, ldc_, ssr_, mode_, tab_, smask_, rmod_, rlim_, cid_) do { pg8::Gemm g_{(Aptr), (Bptr), (M_), (N_), (K_), (lda_), (ldb_)}; pg8::StaticOrder S_; S_.init((M_), (N_), G, (cid_)); \
        pg8::EpiStore<ACT> E_{(Optr), (ldc_), (ssr_), (mode_), (tab_), (smask_), (rmod_), (rlim_)}; pg8::gemm_phase<pg8::EpiStore<ACT>, pg8::StaticOrder, true, true>(lds, g_, S_, E_); } while (0)
#define GEMM_RESID(Aptr, lda_, Bptr, ldb_, M_, N_, K_, Xptr, ldc_, xb_, ssw_) do { pg8::Gemm g_{(Aptr), (Bptr), (M_), (N_), (K_), (lda_), (ldb_)}; pg8::StaticOrder S_; S_.init((M_), (N_), G, bid); \
        pg8::EpiResid E_{(xb_), (ldc_), (ssw_)}; pg8::gemm_phase<pg8::EpiResid, pg8::StaticOrder, true, true>(lds, g_, S_, E_); } while (0)

#define TR(src, K_, N_, nl, dstoff, dstlstride, per_, hi_, sc_, gn_, gstr_) do { const int ipl_ = ((K_) / 64) * ((N_) / 32), tot_ = ipl_ * (nl); \
            for (int it = gw - base; it < tot_; it += ngw) { if (it < 0) continue; const int l_ = it / ipl_, r_ = it - l_ * ipl_; \
                transpose_item((src) + (size_t)l_ * (K_) * (N_), (K_), (N_), Wb + (dstoff) + (size_t)l_ * (dstlstride), scr, r_, lane, (per_), (hi_), (sc_), (gn_) ? (gn_) + (size_t)l_ * (gstr_) : (const float*)nullptr); \
                asm volatile("s_waitcnt lgkmcnt(0)" ::: "memory"); } \
            base = (base + tot_) % ngw; } while (0)
    PHASE({
        const int tid = threadIdx.x, lane = tid & 63, wave = __builtin_amdgcn_readfirstlane(tid >> 6);
        const int gw = bid * 8 + wave, gtid = bid * 512 + tid;
        unsigned char* ws = p.ws;
        bf16_t* Wb = (bf16_t*)(ws + WS_W);
        f32x2* tabA = (f32x2*)(ws + TAB_A); f32x2* tabB = (f32x2*)(ws + TAB_B); f32x2* tabD = (f32x2*)(ws + TAB_D);
        bf16_t* MN = (bf16_t*)(ws + WS_MN); float* lamp = (float*)(ws + WS_CTL);
        LAS float* scr = (LAS float*)(lds + wave * 16384);
        int base = 0;
        TR(p.in[11], 1024, 4096, 4, WL_MI, WL_SZ, 1 << 30, 0, 1.0f, p.in[10], DM);
        TR(p.in[12], 4096, 1024, 4, WL_MO, WL_SZ, 1 << 30, 0, 1.0f, (const float*)nullptr, 0);
        TR(p.in[7], 1024, 512, 4, WL_XQ, WL_SZ, 1 << 30, 1 << 30, 0.08838834764831845f * LOG2E, p.in[5], DM);
        TR(p.in[8], 1024, 1024, 4, WL_XKV, WL_SZ, 1 << 30, 0, 1.0f, (const float*)nullptr, 0);
        TR(p.in[9], 512, 1024, 4, WL_XO, WL_SZ, 1 << 30, 0, 1.0f, (const float*)nullptr, 0);
        TR(p.in[13], 1024, 4608, 1, W_A_IN, 0, 1536, 512, 0.125f * LOG2E, p.in[4] + 0 * DM, 0);
        TR(p.in[14], 512, 1024, 1, W_A_OUT, 0, 1 << 30, 0, 1.0f, (const float*)nullptr, 0);
        TR(p.in[15], 1024, 1536, 1, W_B_IN, 0, 1 << 30, 0, 1.0f, p.in[4] + 1 * DM, 0);
        TR(p.in[18], 1024, 1024, 1, W_B_OUT, 0, 1 << 30, 0, 1.0f, (const float*)nullptr, 0);
        TR(p.in[19], 1024, 3072, 1, W_C_IN, 0, 1 << 30, 1024, 0.125f * LOG2E, p.in[4] + 2 * DM, 0);
        TR(p.in[25], 1024, 1024, 1, W_C_OUT, 0, 1 << 30, 0, 1.0f, (const float*)nullptr, 0);
        TR(p.in[26], 1024, 672, 1, W_D_IN, 0, 1 << 30, 0, 1.0f, p.in[4] + 3 * DM, 0);
        TR(p.in[29], 384, 1536, 1, W_D_UQ, 0, 1 << 30, 1 << 30, 0.10206207261596575f * LOG2E, (const float*)nullptr, 0);
        TR(p.in[30], 256, 2048, 1, W_D_UKV, 0, 1 << 30, 0, 1.0f, (const float*)nullptr, 0);
        TR(p.in[31], 1024, 1024, 1, W_D_OUT, 0, 1 << 30, 0, 1.0f, (const float*)nullptr, 0);
        for (int i = gtid; i < (int)(SS_BYTES / 16); i += gthreads) *(u32x4*)(ws + WS_SS + (size_t)i * 16) = (u32x4){0u, 0u, 0u, 0u};
        for (int i = gtid; i < 96 * 1024 / 8; i += gthreads) *(u32x4*)(Wb + W_D_IN + (size_t)672 * 1024 + (size_t)i * 8) = (u32x4){0u, 0u, 0u, 0u};
        for (int i = gtid; i < 8192 * 8; i += gthreads) tabA[i] = cs_of((double)(i >> 3), p.invfA[i & 7]);
        for (int i = gtid; i < 8192 * 16; i += gthreads) tabD[i] = cs_of((double)(i >> 4), p.invfD[i & 15]);
        for (int i = gtid; i < 128 * 16; i += gthreads) tabB[i] = cs_of((double)(i >> 4), p.invfB[i & 15]);
        if (bid == 0 && wave == 0) { const float a = wave_sum(p.in[20][lane] * p.in[21][lane]), b = wave_sum(p.in[22][lane] * p.in[23][lane]);
            if (lane == 0) lamp[0] = __expf(a) - __expf(b) + p.lam_init;
            float gq = fabsf(p.in[16][lane]), gk = fabsf(p.in[17][lane]);
            _Pragma("unroll") for (int o = 1; o < 64; o <<= 1) { gq = fmaxf(gq, __shfl_xor(gq, o)); gk = fmaxf(gk, __shfl_xor(gk, o)); }
            if (lane == 0) lamp[1] = 8.0f * gq * 8.0f * gk * 0.125f * LOG2E; }
        for (int it = gw; it < DEPTH * NMEMROWS; it += ngw) { const int i = it / NMEMROWS, r = it - i * NMEMROWS;
            const float* src = r < 512 ? p.in[2] + (size_t)r * DM : p.in[3] + (size_t)(r - 512) * DM;
            norm_row_bf16(src, p.in[6] + i * DM, MN + (size_t)it * DM, lane); }
    });
#pragma nounroll
    for (int ch = 0; ch < NCH; ++ch) {
        const int S = ch == 0 ? 8192 : 4096, nseq = TC / S, gseq0 = ch == 0 ? 0 : 2 + 4 * (ch - 1);
        const int nqb = S / 256;
        PHASE({ int tid = threadIdx.x; asm volatile("" : "+v"(tid)); const int lane = tid & 63, wave = __builtin_amdgcn_readfirstlane(tid >> 6); const int gw = bid * 8 + wave;
                unsigned char* wsb = p.ws; asm volatile("" : "+s"(wsb)); wsb = (unsigned char*)(GASP unsigned char*)wsb; float* outb = p.out; asm volatile("" : "+s"(outb)); outb = (float*)(GASP float*)outb;
                const float* xin = ch == 0 ? p.in[0] : p.in[1] + (size_t)(ch - 1) * TC * DM; asm volatile("" : "+s"(xin)); xin = (const float*)(const GASP float*)xin; float* xo = outb + (size_t)ch * TC * DM;
                bf16_t* Hb = (bf16_t*)(wsb + WS_H); unsigned long long* ss0 = (unsigned long long*)(wsb + WS_SS) + (size_t)(ch * 15) * TC;
                for (int r = gw; r < TC; r += ngw) start_row(xin + (size_t)r * DM, Hb + (size_t)r * DM, ss0 + r, lane); });
#pragma nounroll
        for (int li = 0; li < DEPTH; ++li) {
            const int nmix = li == 3 ? 3 : 2;
            const int nsub = 7 + nmix;
#pragma nounroll
            for (int sub2 = 0; sub2 < nsub * PROBE_REP; ++sub2) {
                const int sub = sub2 / PROBE_REP, dup = sub2 % PROBE_REP;
                unsigned char* ws = p.ws; asm volatile("" : "+s"(ws)); ws = (unsigned char*)(GASP unsigned char*)ws;
                float* outp = p.out; asm volatile("" : "+s"(outp)); outp = (float*)(GASP float*)outp;
                int tid = threadIdx.x; asm volatile("" : "+v"(tid));
                const int lane = tid & 63, wave = __builtin_amdgcn_readfirstlane(tid >> 6);
                const int gw = bid * 8 + wave, gtid = bid * 512 + tid;
                const int vcu = (G % 8 == 0) ? (bid % 8) * (G / 8) + bid / 8 : bid;
                bf16_t* Wb = (bf16_t*)(ws + WS_W);
                f32x2* tabA = (f32x2*)(ws + TAB_A); f32x2* tabB = (f32x2*)(ws + TAB_B); f32x2* tabD = (f32x2*)(ws + TAB_D);
                bf16_t* MN = (bf16_t*)(ws + WS_MN); bf16_t* KVM = (bf16_t*)(ws + WS_KVM); bf16_t* H = (bf16_t*)(ws + WS_H); bf16_t* AO = (bf16_t*)(ws + WS_AO);
                float* LSE = (float*)(ws + WS_LSE); bf16_t* BIG = (bf16_t*)(ws + WS_BIG); bf16_t* QX = (bf16_t*)(ws + WS_X2);
                float* lamp = (float*)(ws + WS_CTL);
                float* X = outp + (size_t)ch * TC * DM;
                int op, garg = 0;
                const int ms = sub - 1, tail = sub - 1 - nmix;
                if (sub == 0) { op = 1; garg = 0; }
                else if (ms < nmix) {
                    if (li == 0) op = ms == 0 ? 6 : 11;
                    else if (li == 1) op = ms == 0 ? 3 : 7;
                    else if (li == 2) op = ms == 0 ? 8 : 12;
                    else { op = ms == 0 ? 4 : (ms == 1 ? 1 : 9); garg = 6; }
                } else {
                    switch (tail) { case 0: op = 1; garg = 1; break; case 1: op = 1; garg = 2; break; case 2: op = 10; break;
                                    case 3: op = 1; garg = 3; break; case 4: op = 1; garg = 4; break; default: op = 1; garg = 5; break; }
                }
                unsigned long long* SSl = (unsigned long long*)(ws + WS_SS) + (size_t)((ch * 5 + li) * 3) * TC;
                const bool skip = dup && !((PROBE_ATT2 && op >= 7 && op <= 10) || (PROBE_GST2 && op == 1 && (garg == 0 || garg == 2 || garg == 4 || garg == 6)) || (PROBE_PREP2 && (op == 11 || op == 12)));
                PHASE({
                  if (!skip) {
                    if (op == 1) {
                        const int nrep = (garg == 6 || (garg == 2 && ch == 0)) ? 2 : 1;
_Pragma("nounroll")
                        for (int rep = 0; rep < nrep; ++rep) {
                            const bf16_t* A_ = H; const bf16_t* B_ = Wb; void* O_ = BIG; int lda_ = DM, N_ = 1024, K_ = 1024, M_ = TC, kind = 0; unsigned long long* ss_ = nullptr; int mode_ = 0, rmod_ = 1, rlim_ = 0, cid_ = bid; const float* tab_ = nullptr;
                            if (garg == 0) { B_ = Wb + (li == 0 ? W_A_IN : (li == 1 ? W_B_IN : (li == 2 ? W_C_IN : W_D_IN))); N_ = li == 0 ? 4608 : (li == 1 ? 1536 : (li == 2 ? 3072 : 768)); ss_ = SSl;
                                              if (li == 0) { mode_ = 1; tab_ = (const float*)tabA; rmod_ = 6; rlim_ = 4; } else if (li == 2) { mode_ = 1; tab_ = (const float*)tabA; rmod_ = 1 << 20; rlim_ = 8; } }
                            else if (garg == 1) { A_ = AO; K_ = li == 0 ? 512 : 1024; lda_ = K_; B_ = Wb + (li == 0 ? W_A_OUT : (li == 1 ? W_B_OUT : (li == 2 ? W_C_OUT : W_D_OUT))); O_ = X; kind = 2; ss_ = SSl + TC; }
                            else if (garg == 2) { if (rep == 0) { B_ = Wb + (size_t)li * WL_SZ + WL_XQ; N_ = 512; O_ = QX; ss_ = SSl + TC; }
                                                  else { A_ = MN + (size_t)li * NMEMROWS * DM; B_ = Wb + (size_t)li * WL_SZ + WL_XKV; M_ = NMEMROWS; O_ = KVM + (size_t)li * NMEMROWS * DM; cid_ = (bid + G / 2) % G; } }
                            else if (garg == 3) { A_ = AO; K_ = 512; lda_ = 512; B_ = Wb + (size_t)li * WL_SZ + WL_XO; O_ = X; kind = 2; ss_ = SSl + 2 * TC; }
                            else if (garg == 4) { B_ = Wb + (size_t)li * WL_SZ + WL_MI; N_ = 4096; kind = 1; ss_ = SSl + 2 * TC; }
                            else if (garg == 5) { A_ = BIG; K_ = 4096; lda_ = 4096; B_ = Wb + (size_t)li * WL_SZ + WL_MO; O_ = X; kind = 2; ss_ = SSl + 3 * TC; }
                            else { if (rep == 0) { A_ = BIG + (size_t)12 * MiB; K_ = 384; lda_ = 384; B_ = Wb + W_D_UQ; N_ = 1536; O_ = BIG + (size_t)24 * MiB; mode_ = 2; tab_ = (const float*)tabD; }
                                   else { A_ = BIG + (size_t)18 * MiB; K_ = 256; lda_ = 256; B_ = Wb + W_D_UKV; N_ = 2048; O_ = BIG + (size_t)48 * MiB; } }
                            if (kind == 0) GEMM_STORE(0, A_, lda_, B_, K_, M_, N_, K_, (bf16_t*)O_, N_, (const unsigned long long*)ss_, mode_, tab_, S - 1, rmod_, rlim_, cid_);
                            else if (kind == 1) GEMM_STORE(1, A_, lda_, B_, K_, M_, N_, K_, (bf16_t*)O_, N_, (const unsigned long long*)ss_, 0, (const float*)nullptr, 0, 1, 0, bid);
                            else GEMM_RESID(A_, lda_, B_, K_, M_, N_, K_, (float*)O_, DM, H, ss_);
                        }
                    } else if (op == 3) { prep_b(BIG, p.in[16], p.in[17], S, tabB, gtid, gthreads);
                    } else if (op == 4) { prep_d1(BIG, BIG + (size_t)12 * MiB, BIG + (size_t)18 * MiB, BIG + (size_t)22 * MiB, p.in[27], p.in[28], S, tabD, gw, ngw, lane);
                    } else if (op == 6) {
                        const int nunits = nseq * 3 * 8 * nqb;
_Pragma("nounroll")
                        for (int u = vcu; u < nunits; u += G) {
                            int r = u; const int qb = r % nqb; r /= nqb; const int h = r % 8; r /= 8; const int g = r % 3; const int sq = r / 3;
                            const int dil = g == 0 ? 1 : (g == 1 ? 4 : 16); const int L = S / dil, bpr = L / 256;
                            const int res = qb / bpr, q0 = (qb % bpr) * 256;
                            bf16_t* base = BIG + ((size_t)sq * S + res) * 4608 + g * 1536 + h * 64;
                            AttnArgs a; a.nomax = 0; a.q = base + (size_t)q0 * dil * 4608; a.qs = (long)dil * 4608; a.k = base + 512; a.ks = a.qs; a.k2 = nullptr; a.k2s = 0; a.v = base + 1024; a.vs = a.qs;
                            a.o = base + (size_t)q0 * dil * 4608; a.os = a.qs; a.lse = LSE + ((size_t)g * TC + (size_t)sq * S + res + (size_t)q0 * dil) * 8 + h; a.lses = (long)dil * 8;
                            a.kv_len = L; a.q0 = q0;
                            attn_unit<64, 64, true>(a, lds, tid);
                        }
                    } else if (op == 7) {
                        const int nunits = nseq * 16 * nqb;
_Pragma("nounroll")
                        for (int u = vcu; u < nunits; u += G) {
                            int r = u; const int qb = r % nqb; r /= nqb; const int h = r % 16; const int sq = r / 16;
                            const size_t row0 = (size_t)sq * S;
                            AttnArgs a; a.nomax = 0; a.q = BIG + (row0 + qb * 256) * 1536 + h * 64; a.qs = 1536; a.k = BIG + row0 * 1536 + 1024 + (h >> 2) * 64; a.ks = 1536; a.k2 = nullptr; a.k2s = 0;
                            a.v = BIG + row0 * 1536 + 1280 + (h >> 2) * 64; a.vs = 1536; a.o = AO + (row0 + qb * 256) * 1024 + h * 64; a.os = 1024; a.lse = nullptr; a.lses = 0;
                            a.kv_len = S; a.q0 = qb * 256; a.nomax = lamp[1] <= 40.0f ? 1 : 0;
                            attn_unit<64, 64, false>(a, lds, tid);
                        }
                    } else if (op == 8) {
                        bf16_t* OC = BIG + (size_t)TC * 3072;
                        const int nunits = nseq * 16 * nqb;
_Pragma("nounroll")
                        for (int u = vcu; u < nunits; u += G) {
                            int r = u; const int qb = r % nqb; r /= nqb; const int hc = r % 16; const int sq = r / 16;
                            const size_t row0 = (size_t)sq * S;
                            AttnArgs a; a.nomax = 0; a.q = BIG + (row0 + qb * 256) * 3072 + hc * 64; a.qs = 3072; a.k = BIG + row0 * 3072 + 1024 + hc * 64; a.ks = 3072; a.k2 = nullptr; a.k2s = 0;
                            a.v = BIG + row0 * 3072 + 2048 + (hc >> 1) * 128; a.vs = 3072; a.o = OC + (row0 + qb * 256) * 2048 + hc * 128; a.os = 2048; a.lse = nullptr; a.lses = 0;
                            a.kv_len = S; a.q0 = qb * 256;
                            attn_unit<64, 128, false>(a, lds, tid);
                        }
                    } else if (op == 9) {
                        bf16_t* KR = BIG + (size_t)22 * MiB; bf16_t* QD = BIG + (size_t)24 * MiB; bf16_t* KVD = BIG + (size_t)48 * MiB;
                        const int nunits = nseq * 16 * nqb;
_Pragma("nounroll")
                        for (int u = vcu; u < nunits; u += G) {
                            int r = u; const int qb = r % nqb; r /= nqb; const int h = r % 16; const int sq = r / 16;
                            const size_t row0 = (size_t)sq * S;
                            AttnArgs a; a.nomax = 0; a.q = QD + (row0 + qb * 256) * 1536 + h * 96; a.qs = 1536; a.k = KVD + row0 * 2048 + h * 128; a.ks = 2048; a.k2 = KR + row0 * 32; a.k2s = 32;
                            a.v = KVD + row0 * 2048 + h * 128 + 64; a.vs = 2048; a.o = AO + (row0 + qb * 256) * 1024 + h * 64; a.os = 1024; a.lse = nullptr; a.lses = 0;
                            a.kv_len = S; a.q0 = qb * 256;
                            attn_unit<96, 64, false>(a, lds, tid);
                        }
                    } else if (op == 10) {
                        const int nunits = (TC / 256) * 4;
_Pragma("nounroll")
                        for (int u = vcu; u < nunits; u += G) {
                            const int h = u & 3, rb = u >> 2; const int sq = (rb * 256) / S;
                            const bf16_t* kvb = KVM + ((size_t)li * NMEMROWS + (size_t)(gseq0 + sq) * 256) * DM + h * 128;
                            AttnArgs a; a.nomax = 0; a.q = QX + (size_t)rb * 256 * 512 + h * 128; a.qs = 512; a.k = kvb; a.ks = DM; a.k2 = nullptr; a.k2s = 0; a.v = kvb + 512; a.vs = DM;
                            a.o = AO + (size_t)rb * 256 * 512 + h * 128; a.os = 512; a.lse = nullptr; a.lses = 0; a.kv_len = 256; a.q0 = 0;
                            attn_unit<128, 128, false>(a, lds, tid);
                        }
                    } else if (op == 11) { merge_a(BIG, LSE, AO, gtid, gthreads);
                    } else { combine_c(BIG + (size_t)TC * 3072, AO, p.in[24], lamp[0], p.one_minus_li, gtid, gthreads); }
                  }
                });
            }
        }
        PHASE({ int tid = threadIdx.x; asm volatile("" : "+v"(tid)); const int lane = tid & 63, wave = __builtin_amdgcn_readfirstlane(tid >> 6); const int gw = bid * 8 + wave;
                unsigned char* wsb = p.ws; asm volatile("" : "+s"(wsb)); wsb = (unsigned char*)(GASP unsigned char*)wsb; float* outb = p.out; asm volatile("" : "+s"(outb)); outb = (float*)(GASP float*)outb; const float* fg = p.in[32]; asm volatile("" : "+s"(fg)); fg = (const float*)(const GASP float*)fg;
                const unsigned long long* ssf = (const unsigned long long*)(wsb + WS_SS) + (size_t)((ch * 5 + 4) * 3) * TC; float* xo = outb + (size_t)ch * TC * DM;
                const bf16_t* Hb = (const bf16_t*)(wsb + WS_H);
                for (int r = gw; r < TC; r += ngw) final_row(Hb + (size_t)r * DM, xo + (size_t)r * DM, fg, ((const GASP unsigned long long*)ssf)[r], lane); });
    }
#undef PHASE
}
constexpr int NSTEPS = 1 + NCH * (1 + 4 * 7 + 3 + 2 + 3 + 4) + 1;

extern "C" void kernel_launch(void* const* d_in, const int* in_sizes, int n_in, void* d_out, int out_size, void* d_ws, size_t ws_size, hipStream_t stream) {
    static int grid = 0;
    if (grid == 0) {
        if (n_in != 33 || out_size != NTOK * DM || ws_size < WS_END) { fprintf(stderr, "kernel_launch: unexpected shapes (n_in %d out %d ws %zu)\n", n_in, out_size, ws_size); grid = -1; return; }
        int dev = 0, cus = 0, per_cu = 0;
        (void)hipGetDevice(&dev); (void)hipDeviceGetAttribute(&cus, hipDeviceAttributeMultiprocessorCount, dev);
        if (hipFuncSetAttribute((const void*)mega_fwd, hipFuncAttributeMaxDynamicSharedMemorySize, LDS_BYTES) != hipSuccess) { fprintf(stderr, "kernel_launch: hipFuncSetAttribute failed\n"); grid = -1; return; }
        if (hipOccupancyMaxActiveBlocksPerMultiprocessor(&per_cu, (const void*)mega_fwd, 512, LDS_BYTES) != hipSuccess || per_cu < 1) { fprintf(stderr, "kernel_launch: occupancy query gave %d\n", per_cu); per_cu = 1; }
        (void)hipGetLastError();
        grid = cus * 1;
        fprintf(stderr, "kernel_launch: cus %d per_cu %d grid %d\n", cus, per_cu, grid);
    }
    if (grid < 0) return;
    if (hipMemsetAsync((char*)d_ws + WS_CTL, 0, 65536, stream) != hipSuccess) { fprintf(stderr, "kernel_launch: memset failed\n"); return; }
    Params p{};
    for (int i = 0; i < 33; ++i) p.in[i] = (const float*)d_in[i];
    p.out = (float*)d_out; p.ws = (unsigned char*)d_ws;
    for (int i = 0; i < 8; ++i) p.invfA[i] = std::exp((double)i * (-2.0 * std::log(500000.0) / 16.0));
    for (int i = 0; i < 16; ++i) p.invfD[i] = std::exp((double)i * (-2.0 * std::log(500000.0) / 32.0));
    for (int i = 0; i < 16; ++i) p.invfB[i] = std::exp((double)i * (-2.0 * std::log(10000.0) / 32.0));
    const double li = 0.8 - 0.6 * std::exp(-0.3 * 2.0);
    p.lam_init = (float)li; p.one_minus_li = (float)(1.0 - li);
#if MK_MULTI
    for (int s = 0; s < NSTEPS; ++s) { p.step_lo = s; p.step_hi = s + 1; void* args[] = {&p};
        hipError_t e = hipLaunchCooperativeKernel((const void*)mega_fwd, dim3(grid), dim3(512), args, LDS_BYTES, stream);
        if (e != hipSuccess) { fprintf(stderr, "launch %d failed: %s\n", s, hipGetErrorString(e)); break; } }
#else
    p.step_lo = 0; p.step_hi = 1 << 30; void* args[] = {&p};
    hipError_t e = hipLaunchCooperativeKernel((const void*)mega_fwd, dim3(grid), dim3(512), args, LDS_BYTES, stream);
    if (e != hipSuccess) fprintf(stderr, "cooperative launch failed: %s (grid %d)\n", hipGetErrorString(e), grid);
#endif
}
```
